# Optimizing an MI355X kernel written in HIP

```python
import jax, jax.numpy as jnp
from jax import lax
import numpy as np

D_MODEL = 2048
BATCH = 16
SEQ = 2048
DEPTH = 1

GRID_W = 64
CTX_LEN = 256
D_RET = 1024
RET_HEADS = 4
RET_HD = D_RET // RET_HEADS
RET_CHUNK = 128
D_LRU = 1024
LRU_BLOCKS = 8
LRU_BD = D_LRU // LRU_BLOCKS
CONV_W = 4
CONV_PAD_L = 1
CONV_PAD_R = 2
LRU_C = 8.0
D_MIX = D_RET + D_LRU
D_IN = 4 * D_RET + 2 * D_LRU
N_EXPERTS = 32
TOP_K = 4
D_FF = D_MODEL
SWIGLU_LIMIT = 7.0
SWIGLU_ALPHA = 1.702
MOE_BLOCK = 128
ROPE_THETA = 10000.0
EPS = 1e-6

kernel_name = 'hybrid_retention_rglru_moe_dit_layer'


def _rmsnorm(x, g):
    xf = x.astype(jnp.float32)
    y = xf * lax.rsqrt(jnp.mean(xf * xf, axis=-1, keepdims=True) + EPS)
    return y.astype(x.dtype) * g


def _ada(cond, w, b):
    return jax.nn.silu(cond) @ w + b


def _rope_1d(x, pos):
    half = x.shape[-1] // 2
    inv = ROPE_THETA ** (-jnp.arange(half, dtype=jnp.float32) / half)
    ang = pos.astype(jnp.float32)[:, None] * inv[None, :]
    cos = jnp.cos(ang).astype(x.dtype)
    sin = jnp.sin(ang).astype(x.dtype)
    x1, x2 = x[..., :half], x[..., half:]
    return jnp.concatenate([x1 * cos - x2 * sin, x1 * sin + x2 * cos], axis=-1)


def _rope2d(x, rows, cols):
    hd = x.shape[-1]
    return jnp.concatenate([_rope_1d(x[..., :hd // 2], rows), _rope_1d(x[..., hd // 2:], cols)], axis=-1)


def _ret_log_gamma():
    return jnp.log1p(-(2.0 ** (-5.0 - jnp.arange(RET_HEADS, dtype=jnp.float32))))


def _retention_dir(q, k, v, s0, include_diag):
    B, H, L, hd = q.shape
    C = RET_CHUNK
    N = L // C
    log_g = _ret_log_gamma()
    idx = jnp.arange(C, dtype=jnp.float32)
    diff = idx[:, None] - idx[None, :]
    mask = (diff >= 0) if include_diag else (diff > 0)
    intra_decay = jnp.where(mask[None], jnp.exp(jnp.where(mask, diff, 0.0)[None] * log_g[:, None, None]), 0.0)
    q_decay = jnp.exp((idx + 1.0)[None, :] * log_g[:, None])
    k_decay = jnp.exp((C - 1.0 - idx)[None, :] * log_g[:, None])
    chunk_decay = jnp.exp(C * log_g)

    def to_chunks(t):
        return t.reshape(B, H, N, C, hd).transpose(2, 0, 1, 3, 4)

    def step(s, qkv):
        qc, kc, vc = qkv
        qf, kf, vf = qc.astype(jnp.float32), kc.astype(jnp.float32), vc.astype(jnp.float32)
        scores = jnp.einsum('bhid,bhjd->bhij', qf, kf) * intra_decay[None]
        o = jnp.einsum('bhij,bhjd->bhid', scores, vf) + jnp.einsum('bhid,bhde->bhie', qf, s) * q_decay[None, :, :, None]
        s_new = s * chunk_decay[None, :, None, None] + jnp.einsum('bhjd,bhje->bhde', kf * k_decay[None, :, :, None], vf)
        return s_new, o.astype(q.dtype)

    s_fin, o = lax.scan(step, s0, (to_chunks(q), to_chunks(k), to_chunks(v)))
    o = o.transpose(1, 2, 0, 3, 4).reshape(B, H, L, hd)
    return o, s_fin


def _retention_bidir(q, k, v, s0_f, s0_b):
    o_f, s_f = _retention_dir(q, k, v, s0_f, True)
    flip = lambda t: jnp.flip(t, axis=2)
    o_b, s_b = _retention_dir(flip(q), flip(k), flip(v), s0_b, False)
    return o_f + flip(o_b), s_f, s_b


def _conv_centered(u, w, b):
    L = u.shape[1]
    up = jnp.pad(u, ((0, 0), (CONV_PAD_L, CONV_PAD_R), (0, 0)))
    out = b
    for tap in range(CONV_W):
        out = out + up[:, tap:tap + L] * w[tap]
    return out


def _rglru_dir(u, h0, w_a, b_a, w_x, b_x, lam):
    B, L, Dl = u.shape
    ub = u.reshape(B, L, LRU_BLOCKS, LRU_BD)
    r = jax.nn.sigmoid(jnp.einsum('blhi,hij->blhj', ub, w_a).reshape(B, L, Dl) + b_a)
    i = jax.nn.sigmoid(jnp.einsum('blhi,hij->blhj', ub, w_x).reshape(B, L, Dl) + b_x)
    log_a = (-LRU_C * jax.nn.softplus(-lam.astype(jnp.float32))) * r.astype(jnp.float32)
    a = jnp.exp(log_a)
    bterm = jnp.sqrt(-jnp.expm1(2.0 * log_a)) * (i * u).astype(jnp.float32)
    bterm = bterm.at[:, 0].add(a[:, 0] * h0)

    def comb(e1, e2):
        a1, b1 = e1
        a2, b2 = e2
        return a1 * a2, a2 * b1 + b2

    _, h = lax.associative_scan(comb, (a, bterm), axis=1)
    return h, h[:, -1]


def _rglru_bidir(u, h0_f, h0_b, p):
    h_f, last_f = _rglru_dir(u, h0_f, p['lru_w_a'][0], p['lru_b_a'][0], p['lru_w_x'][0], p['lru_b_x'][0], p['lru_lambda'][0])
    h_b, last_b = _rglru_dir(jnp.flip(u, axis=1), h0_b, p['lru_w_a'][1], p['lru_b_a'][1], p['lru_w_x'][1], p['lru_b_x'][1], p['lru_lambda'][1])
    return h_f + jnp.flip(h_b, axis=1), last_f, last_b


def _head_groupnorm(o):
    of = o.astype(jnp.float32)
    mu = jnp.mean(of, axis=-1, keepdims=True)
    var = jnp.mean(jnp.square(of - mu), axis=-1, keepdims=True)
    return ((of - mu) * lax.rsqrt(var + EPS)).astype(o.dtype)


def _merge(o_ret, g, h_lru, y, p):
    B, H, L, hd = o_ret.shape
    ret = _head_groupnorm(o_ret).transpose(0, 2, 1, 3).reshape(B, L, H * hd)
    ret = ret * p['ret_norm_g'] * jax.nn.silu(g)
    lru = _rmsnorm(h_lru.astype(y.dtype) * jax.nn.gelu(y), p['lru_norm_g'])
    return jnp.concatenate([ret, lru], axis=-1) @ p['w_out']


def _mixer(hx, hc, p, need_ctx_out):
    B, L, _ = hx.shape
    pos = jnp.arange(L)
    rows = pos // GRID_W
    cols = pos % GRID_W
    splits = [D_RET, 2 * D_RET, 3 * D_RET, 4 * D_RET, 4 * D_RET + D_LRU]
    qx, kx, vx, gx, ux, yx = jnp.split(hx @ p['w_in'], splits, axis=-1)
    qc, kc, vc, gc, uc, yc = jnp.split(hc @ p['w_in'], splits, axis=-1)

    def heads(t):
        return t.reshape(t.shape[0], t.shape[1], RET_HEADS, RET_HD).transpose(0, 2, 1, 3)

    scale = RET_HD ** -0.5
    s_zero = jnp.zeros((B, RET_HEADS, RET_HD, RET_HD), jnp.float32)
    oc, s_f, s_b = _retention_bidir(heads(qc), heads(kc) * scale, heads(vc), s_zero, s_zero)
    qx_h = _rope2d(heads(qx), rows, cols)
    kx_h = _rope2d(heads(kx), rows, cols) * scale
    ox, _, _ = _retention_bidir(qx_h, kx_h, heads(vx), s_f, s_b)
    h_zero = jnp.zeros((B, D_LRU), jnp.float32)
    hc_lru, h_f, h_b = _rglru_bidir(_conv_centered(uc, p['conv_w'], p['conv_b']), h_zero, h_zero, p)
    hx_lru, _, _ = _rglru_bidir(_conv_centered(ux, p['conv_w'], p['conv_b']), h_f, h_b, p)
    out_x = _merge(ox, gx, hx_lru, yx, p)
    out_c = _merge(oc, gc, hc_lru, yc, p) if need_ctx_out else None
    return out_x, out_c


def _moe(h, p):
    B, L, D = h.shape
    T = B * L
    TK = T * TOP_K
    hf = h.reshape(T, D)
    logits = (hf @ p['router_w'] + p['router_b']).astype(jnp.float32)
    top_v, top_i = lax.top_k(logits, TOP_K)
    gates = jax.nn.softmax(top_v, axis=-1).astype(h.dtype)
    flat_e = top_i.reshape(-1)
    flat_g = gates.reshape(-1)
    order = jnp.argsort(flat_e)
    sorted_e = flat_e[order]
    counts = jnp.bincount(flat_e, length=N_EXPERTS)
    padded = (counts + MOE_BLOCK - 1) // MOE_BLOCK * MOE_BLOCK
    starts = jnp.cumsum(counts) - counts
    pad_end = jnp.cumsum(padded)
    pad_starts = pad_end - padded
    dest = pad_starts[sorted_e] + (jnp.arange(TK) - starts[sorted_e])
    n_blocks = -(-TK // MOE_BLOCK) + N_EXPERTS
    P = n_blocks * MOE_BLOCK
    buf_tok = jnp.full((P,), T, jnp.int32).at[dest].set((order // TOP_K).astype(jnp.int32))
    buf_gate = jnp.zeros((P,), h.dtype).at[dest].set(flat_g[order])
    blk_e = jnp.clip(jnp.searchsorted(pad_end, jnp.arange(n_blocks) * MOE_BLOCK, side='right'), 0, N_EXPERTS - 1)
    h_pad = jnp.concatenate([hf, jnp.zeros((1, D), h.dtype)], axis=0)

    def body(acc, xs):
        tok, gate, e = xs
        xt = h_pad[tok]
        gl = xt @ p['w_gate'][e] + p['b_gate'][e]
        up = xt @ p['w_up'][e] + p['b_up'][e]
        gl = jnp.minimum(gl, SWIGLU_LIMIT)
        up = jnp.clip(up, -SWIGLU_LIMIT, SWIGLU_LIMIT)
        act = (up + 1.0) * gl * jax.nn.sigmoid(SWIGLU_ALPHA * gl)
        y = act @ p['w_down'][e] + p['b_down'][e]
        return acc.at[tok].add(y * gate[:, None]), None

    acc, _ = lax.scan(body, jnp.zeros((T + 1, D), h.dtype),
                      (buf_tok.reshape(n_blocks, MOE_BLOCK), buf_gate.reshape(n_blocks, MOE_BLOCK), blk_e))
    return acc[:T].reshape(B, L, D)


def setup_inputs(seed: int = 0) -> dict:
    key = jax.random.key(seed)
    ks = jax.random.split(key, 32)
    f32 = jnp.float32
    nrm = lambda k, shape, s: jax.random.normal(k, shape, f32) * s
    a0 = jax.random.uniform(ks[14], (DEPTH, 2, D_LRU), f32, minval=0.9, maxval=0.999)
    pa = a0 ** (1.0 / LRU_C)
    lam = jnp.log(pa) - jnp.log1p(-pa)
    return {
        'x': nrm(ks[0], (BATCH, SEQ, D_MODEL), 1.0),
        'c': nrm(ks[1], (BATCH, D_MODEL), 1.0),
        'ctx': nrm(ks[2], (BATCH, CTX_LEN, D_MODEL), 1.0),
        'c_ctx': nrm(ks[3], (D_MODEL,), 1.0),
        'ada_w': nrm(ks[4], (DEPTH, D_MODEL, 6 * D_MODEL), 0.5 * D_MODEL ** -0.5),
        'ada_b': nrm(ks[5], (DEPTH, 6 * D_MODEL), 0.01),
        'norm1_g': 1.0 + nrm(ks[6], (DEPTH, D_MODEL), 0.02),
        'norm2_g': 1.0 + nrm(ks[7], (DEPTH, D_MODEL), 0.02),
        'w_in': nrm(ks[8], (DEPTH, D_MODEL, D_IN), D_MODEL ** -0.5),
        'conv_w': nrm(ks[9], (DEPTH, CONV_W, D_LRU), CONV_W ** -0.5),
        'conv_b': nrm(ks[10], (DEPTH, D_LRU), 0.01),
        'lru_w_a': nrm(ks[11], (DEPTH, 2, LRU_BLOCKS, LRU_BD, LRU_BD), LRU_BD ** -0.5),
        'lru_b_a': nrm(ks[12], (DEPTH, 2, D_LRU), 0.01),
        'lru_w_x': nrm(ks[13], (DEPTH, 2, LRU_BLOCKS, LRU_BD, LRU_BD), LRU_BD ** -0.5),
        'lru_b_x': nrm(ks[15], (DEPTH, 2, D_LRU), 0.01),
        'lru_lambda': lam,
        'ret_norm_g': 1.0 + nrm(ks[16], (DEPTH, D_RET), 0.02),
        'lru_norm_g': 1.0 + nrm(ks[17], (DEPTH, D_LRU), 0.02),
        'w_out': nrm(ks[18], (DEPTH, D_MIX, D_MODEL), D_MIX ** -0.5),
        'router_w': nrm(ks[19], (DEPTH, D_MODEL, N_EXPERTS), D_MODEL ** -0.5),
        'router_b': nrm(ks[20], (DEPTH, N_EXPERTS), 0.01),
        'w_gate': nrm(ks[21], (DEPTH, N_EXPERTS, D_MODEL, D_FF), D_MODEL ** -0.5),
        'b_gate': nrm(ks[22], (DEPTH, N_EXPERTS, D_FF), 0.01),
        'w_up': nrm(ks[23], (DEPTH, N_EXPERTS, D_MODEL, D_FF), D_MODEL ** -0.5),
        'b_up': nrm(ks[24], (DEPTH, N_EXPERTS, D_FF), 0.01),
        'w_down': nrm(ks[25], (DEPTH, N_EXPERTS, D_FF, D_MODEL), D_FF ** -0.5),
        'b_down': nrm(ks[26], (DEPTH, N_EXPERTS, D_MODEL), 0.01),
        'final_norm_g': 1.0 + nrm(ks[27], (D_MODEL,), 0.02),
    }


def reference(x, c, ctx, c_ctx, ada_w, ada_b, norm1_g, norm2_g, w_in, conv_w, conv_b,
              lru_w_a, lru_b_a, lru_w_x, lru_b_x, lru_lambda, ret_norm_g, lru_norm_g, w_out,
              router_w, router_b, w_gate, b_gate, w_up, b_up, w_down, b_down, final_norm_g):
    for l in range(DEPTH):
        last = l == DEPTH - 1
        mix_p = {'w_in': w_in[l], 'conv_w': conv_w[l], 'conv_b': conv_b[l],
                 'lru_w_a': lru_w_a[l], 'lru_b_a': lru_b_a[l], 'lru_w_x': lru_w_x[l], 'lru_b_x': lru_b_x[l],
                 'lru_lambda': lru_lambda[l], 'ret_norm_g': ret_norm_g[l], 'lru_norm_g': lru_norm_g[l],
                 'w_out': w_out[l]}
        moe_p = {'router_w': router_w[l], 'router_b': router_b[l], 'w_gate': w_gate[l], 'b_gate': b_gate[l],
                 'w_up': w_up[l], 'b_up': b_up[l], 'w_down': w_down[l], 'b_down': b_down[l]}
        mx = _ada(c, ada_w[l], ada_b[l])[:, None, :]
        mc = _ada(c_ctx, ada_w[l], ada_b[l])
        sh1, sc1, g1, sh2, sc2, g2 = jnp.split(mx, 6, axis=-1)
        csh1, csc1, cg1, csh2, csc2, cg2 = jnp.split(mc, 6, axis=-1)
        hx = _rmsnorm(x, norm1_g[l]) * (1.0 + sc1) + sh1
        hc = _rmsnorm(ctx, norm1_g[l]) * (1.0 + csc1) + csh1
        mix_x, mix_c = _mixer(hx, hc, mix_p, not last)
        x = x + g1 * mix_x
        x = x + g2 * _moe(_rmsnorm(x, norm2_g[l]) * (1.0 + sc2) + sh2, moe_p)
        if not last:
            ctx = ctx + cg1 * mix_c
            ctx = ctx + cg2 * _moe(_rmsnorm(ctx, norm2_g[l]) * (1.0 + csc2) + csh2, moe_p)
    return _rmsnorm(x, final_norm_g)
```

```cpp
#include <hip/hip_runtime.h>
#include <cstdio>
#include <cstdint>

#ifndef MK_MULTI
#define MK_MULTI 0
#endif

#define LAS __attribute__((address_space(3)))
#define GAS __attribute__((address_space(1)))
typedef unsigned short bf16_t;
typedef short bf16x8 __attribute__((ext_vector_type(8)));
typedef float f32x4 __attribute__((ext_vector_type(4)));
typedef float f32x2 __attribute__((ext_vector_type(2)));
typedef unsigned u32x4 __attribute__((ext_vector_type(4)));
typedef unsigned u32x2 __attribute__((ext_vector_type(2)));

constexpr int DM = 2048, NB = 16, SEQ = 2048, NCTX = 256;
constexpr int NL = NB * SEQ;
constexpr int NCT = NB * NCTX;
constexpr int NT = NL + NCT;
constexpr int NH = 4, HD = 256, DR = 1024, DL = 1024, DIN = 6144, NE = 32, TOPK = 4;
constexpr int PMAX = 139264;
constexpr int MODW = 6 * DM;
constexpr int LCH = 32, NLCH = (NCTX + SEQ) / LCH;
constexpr float EPS = 1e-6f;

constexpr size_t MiB = 1ull << 20;
constexpr size_t WS_CTL = 0;
constexpr size_t WS_MODP = 1 * MiB;
constexpr size_t WS_MOD = 8 * MiB;
constexpr size_t WS_CS = 9 * MiB;
constexpr size_t WS_RWT = WS_CS + 64 * 1024;
constexpr size_t WS_C8SP = WS_RWT + 256 * 1024;
constexpr size_t WS_TOPI = 10 * MiB;
constexpr size_t WS_TOPG = WS_TOPI + 512 * 1024;
constexpr size_t WS_CNT16 = WS_TOPG + 512 * 1024;
constexpr size_t WS_TOKSLOT = 12 * MiB;
constexpr size_t WS_GATESLOT = WS_TOKSLOT + 1 * MiB;
constexpr size_t WS_SLOTOF = WS_GATESLOT + 1 * MiB;
constexpr size_t WS_TILEE = WS_SLOTOF + 1 * MiB;
constexpr size_t WS_WINT = 16 * MiB;
constexpr size_t WS_WOT = 40 * MiB;
constexpr size_t WS_LRUBT = 48 * MiB;
constexpr size_t WS_WD = 64 * MiB;
constexpr size_t WS_WG = 320 * MiB;
constexpr size_t WS_WU = 576 * MiB;
constexpr size_t DYN = 832 * MiB;
constexpr size_t WS_HX = DYN;
constexpr size_t WS_Q = DYN + 144 * MiB;
constexpr size_t WS_KT = WS_Q + 64 * MiB;
constexpr size_t WS_KTR = WS_KT + 64 * MiB;
constexpr size_t WS_URAW = WS_KTR + 72 * MiB;
constexpr size_t WS_GT = WS_URAW + 72 * MiB;
constexpr size_t WS_YB = WS_GT + 64 * MiB;
constexpr size_t WS_BCAT = WS_YB + 64 * MiB;
constexpr size_t WS_VTC = WS_BCAT + 192 * MiB;
constexpr size_t WS_KR = WS_VTC + 24 * MiB;
constexpr size_t WS_KDF = WS_KR + 64 * MiB;
constexpr size_t WS_KDB = WS_KDF + 72 * MiB;
constexpr size_t WS_U = WS_KDB + 72 * MiB;
constexpr size_t WS_SLOC = WS_U + 72 * MiB;
constexpr size_t WS_SUMA = WS_SLOC + 144 * MiB;
constexpr size_t WS_SUMB = WS_SUMA + 9 * MiB;
constexpr size_t WS_CIN = WS_SUMB + 9 * MiB;
constexpr size_t WS_G = DYN;
constexpr size_t WS_O = DYN + 288 * MiB;
constexpr size_t WS_MRG = WS_KR;
constexpr size_t WS_H2 = DYN;
constexpr size_t WS_ACT = DYN + 128 * MiB;
constexpr size_t WS_Y = WS_ACT + 544 * MiB;
constexpr size_t WS_END = 2048 * MiB;
static_assert(WS_CIN + 9 * MiB <= WS_END && WS_Y + 544 * MiB <= WS_END && WS_G + 288 * MiB <= WS_KTR + 72 * MiB && WS_O + 64 * MiB <= WS_GT && WS_O >= WS_G + 288 * MiB && WS_MRG + 128 * MiB <= WS_KDB, "ws map");

constexpr int CW_BAR = 4096;
constexpr int LDS_RING = 131072, LDS_MISC = LDS_RING, LDS_BYTES = 147456;

__device__ __forceinline__ unsigned cvt_pk_bf16(float lo, float hi) { unsigned r; asm volatile("v_cvt_pk_bf16_f32 %0, %1, %2" : "=v"(r) : "v"(lo), "v"(hi)); return r; }
__device__ __forceinline__ float bf_lo(unsigned w) { return __uint_as_float(w << 16); }
__device__ __forceinline__ float bf_hi(unsigned w) { return __uint_as_float(w & 0xffff0000u); }
__device__ __forceinline__ void unpack8(const u32x4 w, float (&v)[8]) { v[0] = bf_lo(w.x); v[1] = bf_hi(w.x); v[2] = bf_lo(w.y); v[3] = bf_hi(w.y); v[4] = bf_lo(w.z); v[5] = bf_hi(w.z); v[6] = bf_lo(w.w); v[7] = bf_hi(w.w); }
__device__ __forceinline__ u32x4 pack8(const float (&v)[8]) { u32x4 w; w.x = cvt_pk_bf16(v[0], v[1]); w.y = cvt_pk_bf16(v[2], v[3]); w.z = cvt_pk_bf16(v[4], v[5]); w.w = cvt_pk_bf16(v[6], v[7]); return w; }
__device__ __forceinline__ float fexp2(float x) { return __builtin_amdgcn_exp2f(x); }
__device__ __forceinline__ float fexp(float x) { return __builtin_amdgcn_exp2f(x * 1.44269504089f); }
__device__ __forceinline__ float frcp(float x) { return __builtin_amdgcn_rcpf(x); }
__device__ __forceinline__ float fsigmoid(float x) { return frcp(1.0f + fexp(-x)); }
__device__ __forceinline__ float wave_sum(float v) {
#pragma unroll
    for (int o = 1; o < 64; o <<= 1) v += __shfl_xor(v, o);
    return v;
}
#define LDS_WAIT() asm volatile("s_waitcnt lgkmcnt(0)" ::: "memory")
#define VM_WAIT() asm volatile("s_waitcnt vmcnt(0)" ::: "memory")
__device__ __forceinline__ float l2gamma(int h) { return h == 0 ? -0.0458036896f : (h == 1 ? -0.0227200765f : (h == 2 ? -0.0113153091f : -0.0056465633f)); }

#define XB_TMO      128
#define XB_XCNT(j)  (256  + 64 * (j))
#define XB_XSUB(j)  (1280 + 64 * (j))
#define XB_XGEN(j)  (2304 + 64 * (j))
#define XB_TOP      3328
#define XB_TOPGEN   3392
#define XCD_BAR_WORDS 3456
#define XB_SPIN_CAP (1u << 18)
__device__ __forceinline__ unsigned xb_ld(unsigned* p)              { return __hip_atomic_load(p, __ATOMIC_RELAXED, __HIP_MEMORY_SCOPE_AGENT); }
__device__ __forceinline__ unsigned xb_add(unsigned* p, unsigned v) { return __hip_atomic_fetch_add(p, v, __ATOMIC_RELAXED, __HIP_MEMORY_SCOPE_AGENT); }
__device__ __forceinline__ unsigned xb_xcc_id() { return (unsigned)__builtin_amdgcn_s_getreg((3 << 11) | 20) & 0xFu; }
#define XB_SPIN(cond, bar) do { unsigned _sp = 0; while (cond) { __builtin_amdgcn_s_sleep(1); \
    if ((++_sp & 255u) == 0u) { if (xb_ld(&(bar)[XB_TMO])) break; if (_sp > XB_SPIN_CAP) { atomicAdd(&(bar)[XB_TMO], 1u); break; } } } } while (0)
struct XcdBarrier { unsigned* bar; unsigned x; volatile LAS unsigned* st; };
__device__ __forceinline__ XcdBarrier xcd_barrier_post(unsigned* bar, volatile LAS unsigned* st) {
    XcdBarrier b; b.bar = bar; b.x = xb_xcc_id(); b.st = st;
    if (threadIdx.x == 0) (void)xb_add(&bar[XB_XCNT(b.x)], 1u);
    return b;
}
__device__ __forceinline__ void xcd_barrier_complete(unsigned* bar, unsigned x, unsigned& nloc, unsigned& nx) {
    const unsigned G = gridDim.x * gridDim.y * gridDim.z;
    unsigned sum, cnt, mine, sp = 0u;
    for (;;) {
        sum = 0u; cnt = 0u; mine = 0u;
#pragma unroll
        for (unsigned j = 0; j < 16; ++j) { const unsigned c = xb_ld(&bar[XB_XCNT(j)]); sum += c; cnt += (c > 0u) ? 1u : 0u; mine = (j == x) ? c : mine; }
        if (sum == G) break;
        __builtin_amdgcn_s_sleep(1);
        if ((++sp & 255u) == 0u) { if (xb_ld(&bar[XB_TMO])) break; if (sp > XB_SPIN_CAP) { atomicAdd(&bar[XB_TMO], 1u); break; } }
    }
    nloc = mine > 0u ? mine : 1u; nx = cnt > 0u ? cnt : 1u;
}
__device__ __forceinline__ void xcd_barrier(const XcdBarrier& b) {
    asm volatile("s_waitcnt vmcnt(0)" ::: "memory");
    __syncthreads();
    if (threadIdx.x == 0) {
        unsigned* bar = b.bar;
        __builtin_amdgcn_s_waitcnt(0);
        unsigned nloc = b.st[0], nx = b.st[1];
        if (nloc == 0u) { xcd_barrier_complete(bar, b.x, nloc, nx); b.st[0] = nloc; b.st[1] = nx; }
        const unsigned old = xb_add(&bar[XB_XSUB(b.x)], 1u);
        const unsigned gen = old / nloc;
        if (old + 1u == (gen + 1u) * nloc) {
            __builtin_amdgcn_fence(__ATOMIC_RELEASE, "agent");
            asm volatile("s_waitcnt vmcnt(0)" ::: "memory");
            const unsigned og = xb_add(&bar[XB_TOP], 1u);
            const unsigned tg = og / nx;
            if (og + 1u == (tg + 1u) * nx) xb_add(&bar[XB_TOPGEN], 1u);
            else XB_SPIN(xb_ld(&bar[XB_TOPGEN]) == tg, bar);
            __builtin_amdgcn_fence(__ATOMIC_ACQUIRE, "agent");
            xb_add(&bar[XB_XGEN(b.x)], 1u);
            asm volatile("s_waitcnt vmcnt(0)" ::: "memory");
        } else {
            XB_SPIN(xb_ld(&bar[XB_XGEN(b.x)]) == gen, bar);
            __builtin_amdgcn_fence(__ATOMIC_ACQUIRE, "agent");
            asm volatile("s_waitcnt vmcnt(0)" ::: "memory");
        }
    }
    __syncthreads();
}

namespace pg8 {
constexpr int BM = 256, BK = 64, HALF = 128, HTB = HALF * BK * 2, STAGE_BYTES = 8 * HTB, NXCD = 8, WGM = 8;
__host__ __device__ __forceinline__ int lds_byte(int r, int c) { const int st = (r >> 4) * 2 + (c >> 5), rr = r & 15, cc = c & 31, ob = rr * 64 + cc * 2; return st * 1024 + (ob ^ (((ob >> 9) & 1) << 5)); }
__host__ __device__ __forceinline__ void stage_rc(int b, int& R, int& C) { const int st = b / 1024, sb = b % 1024, swz = sb ^ (((sb >> 9) & 1) << 5); R = (st >> 1) * 16 + swz / 64; C = (st & 1) * 32 + (swz % 64) / 2; }
__host__ __device__ __forceinline__ int perm32(int rho) { const int n = rho >> 4, i = rho & 15; return 8 * (i >> 2) + 4 * n + (i & 3); }

struct Unit { const char* a; const char* b0; const char* b1; char* out; const int* gidx; int ldc, r0, c0, e; };
struct Cfg { int lda, ldb, nt; };

__device__ __forceinline__ void static_map(int L, int nM, int nN, int& pm, int& pn) {
    const int nwg = nM * nN; int wgid = L;
    { const int q = nwg / NXCD, r = nwg % NXCD, xcd = wgid % NXCD, off = wgid / NXCD; wgid = (xcd < r ? xcd * (q + 1) : r * (q + 1) + (xcd - r) * q) + off; }
    const int nig = WGM * nN, gid = wgid / nig, fm = gid * WGM, gsz = (nM - fm) < WGM ? (nM - fm) : WGM;
    pm = fm + ((wgid % nig) % gsz); pn = (wgid % nig) / gsz;
}

template <class Epi, class Sched, bool GATHER>
__device__ __forceinline__ void gemm_phase(LAS unsigned char* lds, const Cfg g, const Sched& S, const Epi& E) {
    const int tid = threadIdx.x, wid = __builtin_amdgcn_readfirstlane(tid >> 6), lane = tid & 63, wr = wid >> 2, wc = wid & 3, fr = lane & 15, fq = lane >> 4;
    int nt = g.nt; asm volatile("" : "+s"(nt));
    int R0, C0, R1, C1; stage_rc(tid * 16, R0, C0); stage_rc(tid * 16 + 8192, R1, C1);
    const int Rb0 = Epi::PERM ? ((R0 & ~31) + perm32(R0 & 31)) : R0, Rb1 = Epi::PERM ? ((R1 & ~31) + perm32(R1 & 31)) : R1;
    const unsigned vB0 = (unsigned)(Rb0 * g.ldb + C0) * 2u, vB1 = (unsigned)(Rb1 * g.ldb + C1) * 2u;
    unsigned vA00, vA01, vA10, vA11;
    const size_t kstep = (size_t)(BK * 2);
    const size_t hstepA = (size_t)HALF * g.lda * 2;
    const unsigned ldsw = (unsigned)wid * 1024u;
    const int aoff = lds_byte(wr * 64 + fr, fq * 8), boff = lds_byte(wc * 32 + fr, fq * 8);
#define PG8_SA(b, h) (((b) * 2 + (h)) * HTB)
#define PG8_SB(b, h) ((4 + (b) * 2 + (h)) * HTB)
#define PG8_STAGE(bufoff, gbase, v0, v1) do { \
        __builtin_amdgcn_global_load_lds((const unsigned*)((const char*)(gbase) + (v0)), (LAS unsigned*)(lds + (bufoff) + ldsw), 16, 0, 0); \
        __builtin_amdgcn_global_load_lds((const unsigned*)((const char*)(gbase) + (v1)), (LAS unsigned*)(lds + (bufoff) + ldsw + 8192), 16, 0, 0); } while (0)
#define PG8_LDA(dst, b, h) do { _Pragma("unroll") for (int m = 0; m < 4; ++m) _Pragma("unroll") for (int k = 0; k < 2; ++k) dst[m][k] = *(const LAS bf16x8*)(lds + PG8_SA(b, h) + aoff + m * 2048 + k * 1024); } while (0)
#define PG8_LDB(dst, b, h) do { _Pragma("unroll") for (int n = 0; n < 2; ++n) _Pragma("unroll") for (int k = 0; k < 2; ++k) dst[n][k] = *(const LAS bf16x8*)(lds + PG8_SB(b, h) + boff + n * 2048 + k * 1024); } while (0)
#define PG8_MMA(ai, bj, At, Bt) do { __builtin_amdgcn_s_setprio(1); _Pragma("unroll") for (int m = 0; m < 4; ++m) _Pragma("unroll") for (int n = 0; n < 2; ++n) _Pragma("unroll") for (int k = 0; k < 2; ++k) \
        acc[ai][bj][m][n] = __builtin_amdgcn_mfma_f32_16x16x32_bf16(Bt[n][k], At[m][k], acc[ai][bj][m][n], 0, 0, 0); __builtin_amdgcn_s_setprio(0); } while (0)
#define PG8_WAIT_V(n) asm volatile("s_waitcnt vmcnt(" #n ")" ::: "memory")
#define PG8_WAIT_L(n) asm volatile("s_waitcnt lgkmcnt(" #n ")" ::: "memory")
#define PG8_BAR __builtin_amdgcn_s_barrier()
#define PG8_SCHED __builtin_amdgcn_sched_barrier(0)
    Unit cur, nxt; int ui = 0;
    if (!S.next(0, cur)) return;
    f32x4 acc[2][2][4][2];
#pragma unroll
    for (int a = 0; a < 2; ++a)
#pragma unroll
        for (int b = 0; b < 2; ++b)
#pragma unroll
            for (int m = 0; m < 4; ++m)
#pragma unroll
                for (int n = 0; n < 2; ++n) acc[a][b][m][n] = (f32x4){0.f, 0.f, 0.f, 0.f};
    bf16x8 At[4][2], B0[2][2], B1[2][2];
    const char *cA0, *cA1, *cB0, *cB1;
    if constexpr (GATHER) {
        const int i00 = cur.gidx[R0], i01 = cur.gidx[R1], i10 = cur.gidx[HALF + R0], i11 = cur.gidx[HALF + R1];
        vA00 = (unsigned)(i00 * g.lda + C0) * 2u; vA01 = (unsigned)(i01 * g.lda + C1) * 2u; vA10 = (unsigned)(i10 * g.lda + C0) * 2u; vA11 = (unsigned)(i11 * g.lda + C1) * 2u;
        cA0 = cur.a; cA1 = cur.a;
    } else {
        vA00 = (unsigned)(R0 * g.lda + C0) * 2u; vA01 = (unsigned)(R1 * g.lda + C1) * 2u; vA10 = vA00; vA11 = vA01;
        cA0 = cur.a; cA1 = cur.a + hstepA;
    }
    cB0 = cur.b0; cB1 = cur.b1;
    PG8_STAGE(PG8_SB(0, 0), cB0, vB0, vB1); PG8_STAGE(PG8_SB(0, 1), cB1, vB0, vB1); PG8_STAGE(PG8_SA(0, 0), cA0, vA00, vA01); PG8_STAGE(PG8_SA(0, 1), cA1, vA10, vA11);
    if (wr == 1) PG8_BAR;
    PG8_WAIT_V(2); PG8_BAR;
    PG8_STAGE(PG8_SB(1, 0), cB0 + kstep, vB0, vB1); PG8_STAGE(PG8_SA(1, 0), cA0 + kstep, vA00, vA01); PG8_STAGE(PG8_SB(1, 1), cB1 + kstep, vB0, vB1);
    PG8_WAIT_V(6); PG8_BAR;
    for (;;) {
        const bool has_next = S.next(ui + 1, nxt);
        const char *nA0, *nA1, *nB0, *nB1;
        if (has_next) { nA0 = nxt.a; nA1 = GATHER ? nxt.a : nxt.a + hstepA; nB0 = nxt.b0; nB1 = nxt.b1; } else { nA0 = cA0; nA1 = cA1; nB0 = cB0; nB1 = cB1; }
        for (int t = 0; t < nt; t += 2) {
            const bool last = (t == nt - 2);
            const char* a1h1 = cA1 + (size_t)(t + 1) * kstep;
            const char* a2h0 = last ? nA0 : cA0 + (size_t)(t + 2) * kstep; const char* a2h1 = last ? nA1 : cA1 + (size_t)(t + 2) * kstep;
            const char* b2h0 = last ? nB0 : cB0 + (size_t)(t + 2) * kstep; const char* b2h1 = last ? nB1 : cB1 + (size_t)(t + 2) * kstep;
            PG8_LDB(B0, 0, 0); PG8_LDB(B1, 0, 1); PG8_SCHED; PG8_LDA(At, 0, 0); PG8_STAGE(PG8_SA(1, 1), a1h1, vA10, vA11);
            PG8_WAIT_V(8); PG8_WAIT_L(0); PG8_BAR; PG8_MMA(0, 0, At, B0); PG8_MMA(0, 1, At, B1); PG8_BAR; PG8_SCHED;
            if constexpr (GATHER) {
                if (last && has_next) { const int i00 = nxt.gidx[R0], i01 = nxt.gidx[R1], i10 = nxt.gidx[HALF + R0], i11 = nxt.gidx[HALF + R1];
                    vA00 = (unsigned)(i00 * g.lda + C0) * 2u; vA01 = (unsigned)(i01 * g.lda + C1) * 2u; vA10 = (unsigned)(i10 * g.lda + C0) * 2u; vA11 = (unsigned)(i11 * g.lda + C1) * 2u; }
            }
            PG8_LDA(At, 0, 1); PG8_STAGE(PG8_SB(0, 0), b2h0, vB0, vB1); PG8_STAGE(PG8_SB(0, 1), b2h1, vB0, vB1); PG8_STAGE(PG8_SA(0, 0), a2h0, vA00, vA01);
            PG8_WAIT_V(8); PG8_WAIT_L(0); PG8_BAR; PG8_MMA(1, 0, At, B0); PG8_MMA(1, 1, At, B1); PG8_BAR; PG8_SCHED;
            PG8_LDB(B0, 1, 0); PG8_LDB(B1, 1, 1); PG8_SCHED; PG8_LDA(At, 1, 0); PG8_STAGE(PG8_SA(0, 1), a2h1, vA10, vA11);
            PG8_WAIT_V(8); PG8_WAIT_L(0); PG8_BAR; PG8_MMA(0, 0, At, B0); PG8_MMA(0, 1, At, B1); PG8_BAR; PG8_SCHED;
            PG8_LDA(At, 1, 1); PG8_STAGE(PG8_SB(1, 0), b2h0 + kstep, vB0, vB1); PG8_STAGE(PG8_SB(1, 1), b2h1 + kstep, vB0, vB1); PG8_STAGE(PG8_SA(1, 0), a2h0 + kstep, vA00, vA01);
            PG8_WAIT_V(8); PG8_WAIT_L(0); PG8_BAR; PG8_MMA(1, 0, At, B0); PG8_MMA(1, 1, At, B1); PG8_BAR; PG8_SCHED;
        }
        if (wr == 0) PG8_BAR;
        E(acc, cur, wr, wc, fr, fq);
        if (!has_next) break;
#pragma unroll
        for (int a = 0; a < 2; ++a)
#pragma unroll
            for (int b = 0; b < 2; ++b)
#pragma unroll
                for (int m = 0; m < 4; ++m)
#pragma unroll
                    for (int n = 0; n < 2; ++n) acc[a][b][m][n] = (f32x4){0.f, 0.f, 0.f, 0.f};
        cur = nxt; cA0 = nA0; cA1 = nA1; cB0 = nB0; cB1 = nB1; ++ui;
        if (wr == 1) PG8_BAR;
    }
    PG8_WAIT_V(0);
    PG8_BAR;
#undef PG8_SA
#undef PG8_SB
#undef PG8_STAGE
#undef PG8_LDA
#undef PG8_LDB
#undef PG8_MMA
#undef PG8_WAIT_V
#undef PG8_WAIT_L
#undef PG8_BAR
#undef PG8_SCHED
}
}

struct Args {
    const float* in[28];
    float* out; unsigned char* ws;
    int ph_lo, ph_hi, li, pad;
};
enum { IN_X = 0, IN_C, IN_CTX, IN_CCTX, IN_ADAW, IN_ADAB, IN_N1G, IN_N2G, IN_WIN, IN_CONVW, IN_CONVB, IN_LWA, IN_LBA, IN_LWX, IN_LBX, IN_LAM, IN_RNG, IN_LNG, IN_WOUT,
       IN_RW, IN_RB, IN_WG, IN_BG, IN_WU, IN_BU, IN_WD, IN_BD, IN_FNG };

enum { K_INPROJ = 0, K_SCORES, K_STATE, K_GATES, K_R3, K_OUT, K_MOE1, K_MOE2 };
template <int KIND> struct Sched {
    int G, c; unsigned char* ws; unsigned char* dout;
    __device__ __forceinline__ bool next(int i, pg8::Unit& u) const {
        const long Ll = (long)i * G + c;
        u.gidx = nullptr; u.r0 = 0; u.c0 = 0; u.e = 0;
        if constexpr (KIND == K_INPROJ) {
            if (Ll >= 3776) return false; const int L = (int)Ll;
            const char* HX = (const char*)(ws + WS_HX); const char* WT = (const char*)(ws + WS_WINT);
            if (L < 2624) {
                int pm, pn;
                if (L < 2560) { int pq; pg8::static_map(L, 128, 20, pm, pq); pn = pq < 8 ? pq : pq + 4; }
                else { const int l2 = L - 2560; pm = 128 + (l2 >> 2); pn = 16 + (l2 & 3); }
                u.a = HX + (size_t)pm * 256 * DM * 2; u.b0 = WT + (size_t)pn * 256 * DM * 2; u.b1 = u.b0 + (size_t)128 * DM * 2;
                const int part = pn >> 2;
                const size_t base = part == 0 ? WS_Q : (part == 1 ? WS_KT : (part == 3 ? WS_GT : (part == 4 ? WS_URAW : WS_YB)));
                u.out = (char*)(ws + base) + ((size_t)pm * 256 * 1024 + (size_t)(pn & 3) * 256) * 2; u.ldc = 1024;
            } else {
                int fm, tn; pg8::static_map(L - 2624, 8, 144, fm, tn);
                u.a = WT + (size_t)(1024 + 256 * fm) * DM * 2; u.b0 = HX + (size_t)tn * 256 * DM * 2; u.b1 = u.b0 + (size_t)128 * DM * 2;
                if (fm < 4) { u.out = (char*)(ws + WS_KTR) + ((size_t)fm * 256 * NT + (size_t)tn * 256) * 2; u.ldc = NT; }
                else { const int h = fm - 4;
                    if (tn < 128) { const int b = tn >> 3, cc = tn & 7; u.out = (char*)(ws + WS_BCAT) + (size_t)(((b * 4 + h) * 8 + cc)) * 256 * 768 * 2; }
                    else { const int b = tn - 128; u.out = (char*)(ws + WS_VTC) + (size_t)(b * 4 + h) * 256 * 768 * 2; }
                    u.ldc = 768; }
            }
            return true;
        } else if constexpr (KIND == K_SCORES) {
            if (Ll >= 512) return false; const int L = (int)Ll; const int bh = L >> 3, cc = L & 7, b = bh >> 2, h = bh & 3;
            char* acat = (char*)dout + ((size_t)bh * 2048 + (size_t)cc * 256) * 768 * 2;
            u.a = acat + 256 * 2; u.b0 = (const char*)(ws + WS_KR) + ((size_t)(b * 2048 + cc * 256) * 1024 + (size_t)h * 256) * 2; u.b1 = u.b0 + (size_t)128 * 1024 * 2;
            u.out = acat; u.ldc = 768; u.e = h; return true;
        } else if constexpr (KIND == K_STATE) {
            if (Ll >= 1152) return false; const int L = (int)Ll; const int bh = L / 18, rem = L % 18, ci = rem >> 1, dir = rem & 1, b = bh >> 2, h = bh & 3;
            u.a = ci == 0 ? (const char*)(ws + WS_VTC) + (size_t)bh * 256 * 768 * 2 : (const char*)(ws + WS_BCAT) + (size_t)(bh * 8 + (ci - 1)) * 256 * 768 * 2;
            const size_t tok0 = ci == 0 ? (size_t)NL + (size_t)b * 256 : (size_t)b * 2048 + (size_t)(ci - 1) * 256;
            u.b0 = (const char*)(ws + (dir ? WS_KDB : WS_KDF)) + ((size_t)h * 256 * NT + tok0) * 2; u.b1 = u.b0 + (size_t)128 * NT * 2;
            u.out = (char*)(ws + WS_SLOC) + (size_t)((bh * 2 + dir) * 9 + ci) * 65536 * 2; u.ldc = 256; return true;
        } else if constexpr (KIND == K_GATES) {
            if (Ll >= 2304) return false; int pm, pn; pg8::static_map((int)Ll, 144, 16, pm, pn);
            u.a = (const char*)(ws + WS_U) + ((size_t)pm * 256 * 1024 + (size_t)(pn >> 1) * 128) * 2;
            u.b0 = (const char*)(ws + WS_LRUBT) + (size_t)pn * 256 * 128 * 2; u.b1 = u.b0 + (size_t)128 * 128 * 2;
            u.out = (char*)(ws + WS_G) + ((size_t)pm * 256 * 4096 + (size_t)pn * 256) * 2; u.ldc = 4096; return true;
        } else if constexpr (KIND == K_R3) {
            if (Ll >= 512) return false; const int L = (int)Ll; const int bh = L >> 3, cc = L & 7, b = bh >> 2, h = bh & 3;
            u.a = (const char*)dout + ((size_t)bh * 2048 + (size_t)cc * 256) * 768 * 2;
            u.b0 = (const char*)(ws + WS_BCAT) + (size_t)(bh * 8 + cc) * 256 * 768 * 2; u.b1 = u.b0 + (size_t)128 * 768 * 2;
            u.out = (char*)(ws + WS_O) + ((size_t)(b * 2048 + cc * 256) * 1024 + (size_t)h * 256) * 2; u.ldc = 1024; return true;
        } else if constexpr (KIND == K_OUT) {
            if (Ll >= 1024) return false; int pm, pn; pg8::static_map((int)Ll, 128, 8, pm, pn);
            u.a = (const char*)(ws + WS_MRG) + (size_t)pm * 256 * DM * 2; u.b0 = (const char*)(ws + WS_WOT) + (size_t)pn * 256 * DM * 2; u.b1 = u.b0 + (size_t)128 * DM * 2;
            u.out = nullptr; u.ldc = DM; u.r0 = pm * 256; u.c0 = pn * 256; return true;
        } else if constexpr (KIND == K_MOE1) {
            const int* tile_e = (const int*)(ws + WS_TILEE); const int ntl = tile_e[1024];
            if (Ll >= (long)ntl * 16) return false; int mt, pn; pg8::static_map((int)Ll, ntl, 16, mt, pn);
            const int e = tile_e[mt];
            u.a = (const char*)(ws + WS_H2); u.gidx = (const int*)(ws + WS_TOKSLOT) + mt * 256;
            u.b0 = (const char*)(ws + WS_WG) + ((size_t)e * 2048 + (size_t)pn * 128) * DM * 2; u.b1 = (const char*)(ws + WS_WU) + ((size_t)e * 2048 + (size_t)pn * 128) * DM * 2;
            u.out = (char*)(ws + WS_ACT) + ((size_t)mt * 256 * DM + (size_t)pn * 128) * 2; u.ldc = DM; u.r0 = mt * 256; u.c0 = pn * 128; u.e = e; return true;
        } else {
            const int* tile_e = (const int*)(ws + WS_TILEE); const int ntl = tile_e[1024];
            if (Ll >= (long)ntl * 8) return false; int mt, pn; pg8::static_map((int)Ll, ntl, 8, mt, pn);
            const int e = tile_e[mt];
            u.a = (const char*)(ws + WS_ACT) + (size_t)mt * 256 * DM * 2;
            u.b0 = (const char*)(ws + WS_WD) + ((size_t)e * 2048 + (size_t)pn * 256) * DM * 2; u.b1 = u.b0 + (size_t)128 * DM * 2;
            u.out = (char*)(ws + WS_Y) + ((size_t)mt * 256 * DM + (size_t)pn * 256) * 2; u.ldc = DM; u.r0 = mt * 256; u.c0 = pn * 256; u.e = e; return true;
        }
    }
};

struct EpiPlain {
    static constexpr bool PERM = true;
    __device__ __forceinline__ void operator()(const f32x4 (&acc)[2][2][4][2], const pg8::Unit& u, int wr, int wc, int fr, int fq) const {
        bf16_t* base = (bf16_t*)u.out + (size_t)(wr * 64 + fr) * u.ldc + wc * 32 + 8 * fq;
#pragma unroll
        for (int ai = 0; ai < 2; ++ai)
#pragma unroll
            for (int m = 0; m < 4; ++m) { bf16_t* rowp = base + (size_t)(ai * 128 + m * 16) * u.ldc;
#pragma unroll
                for (int bj = 0; bj < 2; ++bj) { const f32x4 v0 = acc[ai][bj][m][0], v1 = acc[ai][bj][m][1];
                    u32x4 w; w.x = cvt_pk_bf16(v0[0], v0[1]); w.y = cvt_pk_bf16(v0[2], v0[3]); w.z = cvt_pk_bf16(v1[0], v1[1]); w.w = cvt_pk_bf16(v1[2], v1[3]);
                    *(u32x4*)(rowp + bj * 128) = w; } }
    }
};
struct EpiScores {
    static constexpr bool PERM = true;
    __device__ __forceinline__ void operator()(const f32x4 (&acc)[2][2][4][2], const pg8::Unit& u, int wr, int wc, int fr, int fq) const {
        const float lg = l2gamma(u.e);
        bf16_t* base = (bf16_t*)u.out + (size_t)(wr * 64 + fr) * u.ldc + wc * 32 + 8 * fq;
        int iz = wr * 64 + fr; asm volatile("" : "+v"(iz));
#pragma unroll
        for (int ai = 0; ai < 2; ++ai)
#pragma unroll
            for (int m = 0; m < 4; ++m) { const int i = ai * 128 + m * 16 + iz; bf16_t* rowp = base + (size_t)(ai * 128 + m * 16) * u.ldc;
#pragma unroll
                for (int bj = 0; bj < 2; ++bj) { float o[8];
#pragma unroll
                    for (int n = 0; n < 2; ++n)
#pragma unroll
                        for (int q = 0; q < 4; ++q) { const int j = bj * 128 + wc * 32 + 8 * fq + 4 * n + q; const int d = i - j; const int ad = d < 0 ? -d : d;
                            o[n * 4 + q] = acc[ai][bj][m][n][q] * fexp2((float)(ad - i - 1) * lg); }
                    *(u32x4*)(rowp + bj * 128) = pack8(o); }
                __builtin_amdgcn_sched_barrier(0); }
    }
};
struct EpiOut {
    static constexpr bool PERM = false;
    const float* x; const float* mod; float* X1;
    __device__ __forceinline__ void operator()(const f32x4 (&acc)[2][2][4][2], const pg8::Unit& u, int wr, int wc, int fr, int fq) const {
        const int row0 = u.r0 + wr * 64 + fr, col0 = u.c0 + wc * 32 + 4 * fq; const int b = u.r0 >> 11;
        f32x4 gv[2][2];
#pragma unroll
        for (int bj = 0; bj < 2; ++bj)
#pragma unroll
            for (int n = 0; n < 2; ++n) gv[bj][n] = *(const f32x4*)(mod + (size_t)b * MODW + 2 * DM + col0 + bj * 128 + n * 16);
#pragma unroll
        for (int ai = 0; ai < 2; ++ai)
#pragma unroll
            for (int m = 0; m < 4; ++m) { const size_t off = (size_t)(row0 + ai * 128 + m * 16) * DM + col0;
#pragma unroll
                for (int bj = 0; bj < 2; ++bj)
#pragma unroll
                    for (int n = 0; n < 2; ++n) { const f32x4 xv = *(const f32x4*)(x + off + bj * 128 + n * 16);
                        *(f32x4*)(X1 + off + bj * 128 + n * 16) = xv + gv[bj][n] * acc[ai][bj][m][n]; }
                asm volatile("" ::: "memory"); }
    }
};
struct EpiSwiGLU {
    static constexpr bool PERM = true;
    const float* bg; const float* bu;
    __device__ __forceinline__ void operator()(const f32x4 (&acc)[2][2][4][2], const pg8::Unit& u, int wr, int wc, int fr, int fq) const {
        const int cl = wc * 32 + 8 * fq;
        const float* pg_ = bg + (size_t)u.e * DM + u.c0 + cl; const float* pu_ = bu + (size_t)u.e * DM + u.c0 + cl;
        const f32x4 g0 = *(const f32x4*)pg_, g1 = *(const f32x4*)(pg_ + 4), u0 = *(const f32x4*)pu_, u1 = *(const f32x4*)(pu_ + 4);
        bf16_t* base = (bf16_t*)u.out + (size_t)(wr * 64 + fr) * DM + cl;
#pragma unroll
        for (int ai = 0; ai < 2; ++ai)
#pragma unroll
            for (int m = 0; m < 4; ++m) { float o[8];
#pragma unroll
                for (int n = 0; n < 2; ++n)
#pragma unroll
                    for (int q = 0; q < 4; ++q) { float gl = acc[ai][0][m][n][q] + (n ? g1[q] : g0[q]); float up = acc[ai][1][m][n][q] + (n ? u1[q] : u0[q]);
                        gl = fminf(gl, 7.0f); up = fminf(fmaxf(up, -7.0f), 7.0f);
                        o[n * 4 + q] = (up + 1.0f) * gl * frcp(1.0f + fexp2(gl * (-1.702f * 1.44269504089f))); }
                *(u32x4*)(base + (size_t)(ai * 128 + m * 16) * DM) = pack8(o); }
    }
};
struct EpiDown {
    static constexpr bool PERM = true;
    const float* bd; const float* gate;
    __device__ __forceinline__ void operator()(const f32x4 (&acc)[2][2][4][2], const pg8::Unit& u, int wr, int wc, int fr, int fq) const {
        const int cl = wc * 32 + 8 * fq; const float* pb = bd + (size_t)u.e * DM + u.c0 + cl;
        f32x4 bv[2][2];
#pragma unroll
        for (int bj = 0; bj < 2; ++bj) { bv[bj][0] = *(const f32x4*)(pb + bj * 128); bv[bj][1] = *(const f32x4*)(pb + bj * 128 + 4); }
        bf16_t* base = (bf16_t*)u.out + (size_t)(wr * 64 + fr) * DM + cl;
#pragma unroll
        for (int ai = 0; ai < 2; ++ai)
#pragma unroll
            for (int m = 0; m < 4; ++m) { const float gt = gate[u.r0 + ai * 128 + wr * 64 + m * 16 + fr]; bf16_t* rowp = base + (size_t)(ai * 128 + m * 16) * DM;
#pragma unroll
                for (int bj = 0; bj < 2; ++bj) { const f32x4 v0 = (acc[ai][bj][m][0] + bv[bj][0]) * gt, v1 = (acc[ai][bj][m][1] + bv[bj][1]) * gt;
                    u32x4 w; w.x = cvt_pk_bf16(v0[0], v0[1]); w.y = cvt_pk_bf16(v0[2], v0[3]); w.z = cvt_pk_bf16(v1[0], v1[1]); w.w = cvt_pk_bf16(v1[2], v1[3]);
                    *(u32x4*)(rowp + bj * 128) = w; } }
    }
};

struct Frame {
    LAS unsigned char* lds; unsigned char* ws; float* out; const float* const* in;
    int tid, lane, wave, G, bid;
};
#define INP(k) (F.in[k])

__device__ __forceinline__ void p0_transpose_item(const float* W, int K, int N, bf16_t* WT, int row_off, LAS float* scr, int item, int lane) {
    const int nblk = N / 32, kb = item / nblk, nb = item % nblk, k0 = 64 * kb, n0 = 32 * nb;
#pragma unroll 8
    for (int i = 0; i < 32; ++i) { const int kk = 2 * i + (lane >> 5); scr[kk * 33 + (lane & 31)] = W[(size_t)(k0 + kk) * N + n0 + (lane & 31)]; }
    LDS_WAIT(); asm volatile("" ::: "memory");
    const int c = lane & 7;
#pragma unroll
    for (int j = 0; j < 4; ++j) { const int n = (lane >> 3) + 8 * j; const LAS float* s = scr + (8 * c) * 33 + n;
        u32x4 o; o.x = cvt_pk_bf16(s[0 * 33], s[1 * 33]); o.y = cvt_pk_bf16(s[2 * 33], s[3 * 33]); o.z = cvt_pk_bf16(s[4 * 33], s[5 * 33]); o.w = cvt_pk_bf16(s[6 * 33], s[7 * 33]);
        *(u32x4*)(WT + (size_t)(row_off + n0 + n) * K + k0 + 8 * c) = o; }
    LDS_WAIT(); asm volatile("" ::: "memory");
}
__device__ __forceinline__ void p0_ada_item(Frame& F, int item, LAS float* scr) {
    const int ks = item & 7, cg = item >> 3, n = cg * 64 + F.lane;
    const float* c = INP(IN_C); const float* cc = INP(IN_CCTX); const float* W = INP(IN_ADAW);
    float acc[17];
#pragma unroll
    for (int b = 0; b < 17; ++b) acc[b] = 0.f;
    for (int sub = 0; sub < 4; ++sub) {
        const int k0 = ks * 256 + sub * 64;
#pragma unroll
        for (int b = 0; b < 17; ++b) { const float v = b < 16 ? c[b * DM + k0 + F.lane] : cc[k0 + F.lane]; scr[F.lane * 20 + b] = v * fsigmoid(v); }
        LDS_WAIT(); asm volatile("" ::: "memory");
#pragma unroll 8
        for (int kk = 0; kk < 64; ++kk) { const float w = W[(size_t)(k0 + kk) * MODW + n];
            const LAS f32x4* sp = (const LAS f32x4*)(scr + kk * 20); const f32x4 s0 = sp[0], s1 = sp[1], s2 = sp[2], s3 = sp[3]; const float s16 = scr[kk * 20 + 16];
#pragma unroll
            for (int q = 0; q < 4; ++q) { acc[q] += s0[q] * w; acc[4 + q] += s1[q] * w; acc[8 + q] += s2[q] * w; acc[12 + q] += s3[q] * w; }
            acc[16] += s16 * w; }
        LDS_WAIT(); asm volatile("" ::: "memory");
    }
    float* mp = (float*)(F.ws + WS_MODP) + (size_t)ks * 17 * MODW + n;
#pragma unroll
    for (int b = 0; b < 17; ++b) mp[(size_t)b * MODW] = acc[b];
}
__device__ __forceinline__ void p0_prologue(Frame& F) {
    LAS float* scr = (LAS float*)(F.lds + F.wave * 16384);
    const int gw = F.bid * 8 + F.wave, NGW = F.G * 8;
    constexpr int I_ADA = 1536, I_IN = 32 * 192, I_OUT = 32 * 64, I_EXP = 96 * 2048, I_LRU = 32 * 8;
    constexpr int NITEMS = I_ADA + I_IN + I_OUT + I_EXP + I_LRU;
    for (int it = gw; it < NITEMS; it += NGW) {
        int r = it;
        if (r < I_ADA) { p0_ada_item(F, r, scr); continue; } r -= I_ADA;
        if (r < I_IN) { p0_transpose_item(INP(IN_WIN), DM, DIN, (bf16_t*)(F.ws + WS_WINT), 0, scr, r, F.lane); continue; } r -= I_IN;
        if (r < I_OUT) { p0_transpose_item(INP(IN_WOUT), DM, DM, (bf16_t*)(F.ws + WS_WOT), 0, scr, r, F.lane); continue; } r -= I_OUT;
        if (r < I_EXP) { const int m = r >> 11, item = r & 2047, which = m >> 5, e = m & 31;
            const float* W = (which == 0 ? INP(IN_WG) : (which == 1 ? INP(IN_WU) : INP(IN_WD))) + (size_t)e * DM * DM;
            bf16_t* WT = (bf16_t*)(F.ws + (which == 0 ? WS_WG : (which == 1 ? WS_WU : WS_WD))) + (size_t)e * DM * DM;
            p0_transpose_item(W, DM, DM, WT, 0, scr, item, F.lane); continue; } r -= I_EXP;
        { const int mat = r >> 3, item = r & 7, which = mat >> 4, d = (mat >> 3) & 1, h = mat & 7;
          const float* W = (which == 0 ? INP(IN_LWA) : INP(IN_LWX)) + (size_t)(d * 8 + h) * 128 * 128;
          p0_transpose_item(W, 128, 128, (bf16_t*)(F.ws + WS_LRUBT), h * 512 + d * 256 + which * 128, scr, item, F.lane); }
    }
    const int gt = F.bid * 512 + F.tid, NGT = F.G * 512;
    for (int i = gt; i < 64 * 64; i += NGT) { const int pos = i >> 6, fi = i & 63;
        const float inv = fexp2(-(float)fi * (13.2877123795f / 64.0f)); const float rev = (float)pos * inv * 0.15915494309f; const float fr_ = rev - floorf(rev);
        ((f32x2*)(F.ws + WS_CS))[i] = (f32x2){__builtin_amdgcn_cosf(fr_), __builtin_amdgcn_sinf(fr_)}; }
    for (int i = gt; i < NE * DM; i += NGT) { const int e = i >> 11, k = i & 2047; ((float*)(F.ws + WS_RWT))[i] = INP(IN_RW)[(size_t)k * NE + e]; }
    for (int i = gt; i < 2 * DL; i += NGT) { const float lam = INP(IN_LAM)[i]; const float z = fexp(-lam);
        const float sp = z < 0.03f ? z * (1.0f - z * (0.5f - z * (0.33333333f - 0.25f * z))) : __builtin_amdgcn_logf(1.0f + z) * 0.69314718056f;
        ((float*)(F.ws + WS_C8SP))[i] = -8.0f * sp; }
}
__device__ __forceinline__ void p0b_mod(Frame& F) {
    const float* mp = (const float*)(F.ws + WS_MODP); float* mod = (float*)(F.ws + WS_MOD);
    for (int i = F.bid * 512 + F.tid; i < 17 * MODW; i += F.G * 512) { float s = INP(IN_ADAB)[i % MODW];
#pragma unroll
        for (int ks = 0; ks < 8; ++ks) s += mp[(size_t)ks * 17 * MODW + i];
        mod[i] = s; }
}
__device__ __forceinline__ void p1_norm1(Frame& F) {
    const float* mod = (const float*)(F.ws + WS_MOD); const float* n1g = INP(IN_N1G);
    bf16_t* HX = (bf16_t*)(F.ws + WS_HX);
    for (int row = F.bid * 8 + F.wave; row < NT; row += F.G * 8) {
        const int b = row < NL ? (row >> 11) : 16;
        const float* xr = row < NL ? INP(IN_X) + (size_t)row * DM : INP(IN_CTX) + (size_t)(row - NL) * DM;
        const f32x4* xp = (const f32x4*)xr + F.lane; f32x4 v[8]; float s = 0.f;
#pragma unroll
        for (int j = 0; j < 8; ++j) { v[j] = xp[64 * j]; s += (v[j].x * v[j].x + v[j].y * v[j].y) + (v[j].z * v[j].z + v[j].w * v[j].w); }
        const float rstd = 1.0f / sqrtf(wave_sum(s) * (1.0f / DM) + EPS);
        const f32x4* gp = (const f32x4*)n1g + F.lane; const f32x4* shp = (const f32x4*)(mod + (size_t)b * MODW) + F.lane; const f32x4* scp = (const f32x4*)(mod + (size_t)b * MODW + DM) + F.lane;
        u32x2* op = (u32x2*)(HX + (size_t)row * DM) + F.lane;
#pragma unroll
        for (int j = 0; j < 8; ++j) { const f32x4 g = gp[64 * j], sh = shp[64 * j], sc = scp[64 * j];
            const f32x4 y = v[j] * rstd * g * (1.0f + sc) + sh; u32x2 w; w.x = cvt_pk_bf16(y.x, y.y); w.y = cvt_pk_bf16(y.z, y.w); op[64 * j] = w; }
    }
}

__device__ __forceinline__ void p3_prep(Frame& F) {
    const int gt = F.bid * 512 + F.tid, NGT = F.G * 512;
    const f32x2* cs = (const f32x2*)(F.ws + WS_CS);
    {
        const bf16_t* Q = (const bf16_t*)(F.ws + WS_Q); const bf16_t* KT = (const bf16_t*)(F.ws + WS_KT);
        bf16_t* KR = (bf16_t*)(F.ws + WS_KR); bf16_t* AC = (bf16_t*)F.out;
        for (int it = gt; it < NL * 128; it += NGT) {
            const int row = it >> 7, sub = it & 127, which = sub >> 6, h = (sub >> 4) & 3, half = (sub >> 3) & 1, c8 = sub & 7;
            const int p = row & 2047, comp = half == 0 ? (p >> 6) : (p & 63);
            const int d1 = half * 128 + c8 * 8;
            const bf16_t* src = (which == 0 ? Q : KT) + (size_t)row * 1024 + h * 256 + d1;
            float x1[8], x2[8], o1[8], o2[8]; unpack8(*(const u32x4*)src, x1); unpack8(*(const u32x4*)(src + 64), x2);
            const f32x4* cp = (const f32x4*)(cs + comp * 64 + c8 * 8);
#pragma unroll
            for (int q = 0; q < 4; ++q) { const f32x4 t = cp[q];
                o1[2 * q] = x1[2 * q] * t.x - x2[2 * q] * t.y; o2[2 * q] = x1[2 * q] * t.y + x2[2 * q] * t.x;
                o1[2 * q + 1] = x1[2 * q + 1] * t.z - x2[2 * q + 1] * t.w; o2[2 * q + 1] = x1[2 * q + 1] * t.w + x2[2 * q + 1] * t.z; }
            if (which == 0) {
                const int i = row & 255, b = row >> 11, t_ = row & 2047; const float lg = l2gamma(h);
                const float ff = fexp2((float)(i + 1) * lg), fb = fexp2((float)(256 - i) * lg);
                bf16_t* dst = AC + ((size_t)(b * 4 + h) * 2048 + t_) * 768 + 256 + d1;
                float a[8], c[8];
#pragma unroll
                for (int q = 0; q < 8; ++q) { a[q] = o1[q] * ff; c[q] = o1[q] * fb; }
                *(u32x4*)dst = pack8(a); *(u32x4*)(dst + 256) = pack8(c);
#pragma unroll
                for (int q = 0; q < 8; ++q) { a[q] = o2[q] * ff; c[q] = o2[q] * fb; }
                *(u32x4*)(dst + 64) = pack8(a); *(u32x4*)(dst + 256 + 64) = pack8(c);
            } else {
                bf16_t* dst = KR + (size_t)row * 1024 + h * 256 + d1;
#pragma unroll
                for (int q = 0; q < 8; ++q) { o1[q] *= 0.0625f; o2[q] *= 0.0625f; }
                *(u32x4*)dst = pack8(o1); *(u32x4*)(dst + 64) = pack8(o2);
            }
        }
    }
    {
        const bf16_t* KTR = (const bf16_t*)(F.ws + WS_KTR); bf16_t* KDF = (bf16_t*)(F.ws + WS_KDF); bf16_t* KDB = (bf16_t*)(F.ws + WS_KDB);
        constexpr int NTG = NT / 8;
        for (int it = gt; it < 512 * NTG; it += NGT) {
            const int fp = it / NTG, tg = it - fp * NTG, h = fp >> 7, half = (fp >> 6) & 1, cc = fp & 63;
            const int f1 = h * 256 + half * 128 + cc, tok0 = tg * 8;
            float x1[8], x2[8], o1[8], o2[8];
            unpack8(*(const u32x4*)(KTR + (size_t)f1 * NT + tok0), x1); unpack8(*(const u32x4*)(KTR + (size_t)(f1 + 64) * NT + tok0), x2);
            if (tok0 < NL) {
                const int p0 = tok0 & 2047;
#pragma unroll
                for (int q = 0; q < 8; ++q) { const int comp = half == 0 ? (p0 >> 6) : ((p0 & 63) + q); const f32x2 t = cs[comp * 64 + cc];
                    o1[q] = x1[q] * t.x - x2[q] * t.y; o2[q] = x1[q] * t.y + x2[q] * t.x; }
            } else {
#pragma unroll
                for (int q = 0; q < 8; ++q) { o1[q] = x1[q]; o2[q] = x2[q]; }
            }
            const float lg = l2gamma(h); const int j0 = tok0 & 255;
            float a1[8], a2[8], c1[8], c2[8];
#pragma unroll
            for (int q = 0; q < 8; ++q) { const float df = 0.0625f * fexp2((float)(255 - j0 - q) * lg), db = 0.0625f * fexp2((float)(j0 + q) * lg);
                a1[q] = o1[q] * df; a2[q] = o2[q] * df; c1[q] = o1[q] * db; c2[q] = o2[q] * db; }
            *(u32x4*)(KDF + (size_t)f1 * NT + tok0) = pack8(a1); *(u32x4*)(KDF + (size_t)(f1 + 64) * NT + tok0) = pack8(a2);
            *(u32x4*)(KDB + (size_t)f1 * NT + tok0) = pack8(c1); *(u32x4*)(KDB + (size_t)(f1 + 64) * NT + tok0) = pack8(c2);
        }
    }
    {
        const bf16_t* UR = (const bf16_t*)(F.ws + WS_URAW); bf16_t* U = (bf16_t*)(F.ws + WS_U);
        const float* cw = INP(IN_CONVW); const float* cb = INP(IN_CONVB);
        for (int it = gt; it < NT * 128; it += NGT) {
            const int row = it >> 7, ch = (it & 127) * 8;
            const int t = row < NL ? (row & 2047) : ((row - NL) & 255), Ls = row < NL ? SEQ : NCTX;
            float o[8]; { const f32x4 b0 = *(const f32x4*)(cb + ch), b1 = *(const f32x4*)(cb + ch + 4);
#pragma unroll
                for (int q = 0; q < 4; ++q) { o[q] = b0[q]; o[4 + q] = b1[q]; } }
#pragma unroll
            for (int tap = 0; tap < 4; ++tap) { const int tt = t + tap - 1;
                if (tt >= 0 && tt < Ls) { float x[8]; unpack8(*(const u32x4*)(UR + (size_t)(row + tap - 1) * 1024 + ch), x);
                    const f32x4 w0 = *(const f32x4*)(cw + tap * DL + ch), w1 = *(const f32x4*)(cw + tap * DL + ch + 4);
#pragma unroll
                    for (int q = 0; q < 4; ++q) { o[q] += x[q] * w0[q]; o[4 + q] += x[4 + q] * w1[q]; } } }
            *(u32x4*)(U + (size_t)row * 1024 + ch) = pack8(o);
        }
    }
}

struct LruCh { float ba0, ba1, bx0, bx1, k0, k1; };
__device__ __forceinline__ void lru_ab(const LruCh& P, unsigned rw, unsigned iw, unsigned uw, float& a0, float& b0, float& a1, float& b1) {
    const float r0 = fsigmoid(bf_lo(rw) + P.ba0), r1 = fsigmoid(bf_hi(rw) + P.ba1), i0 = fsigmoid(bf_lo(iw) + P.bx0), i1 = fsigmoid(bf_hi(iw) + P.bx1);
    a0 = fexp(P.k0 * r0); a1 = fexp(P.k1 * r1);
    b0 = sqrtf(fmaxf((1.0f - a0) * (1.0f + a0), 0.f)) * (i0 * bf_lo(uw)); b1 = sqrtf(fmaxf((1.0f - a1) * (1.0f + a1), 0.f)) * (i1 * bf_hi(uw));
}
__device__ __forceinline__ int lru_row(int b, int d, int s) {
    if (s < NCTX) return NL + b * NCTX + (d ? (NCTX - 1 - s) : s);
    const int pl = s - NCTX; return b * SEQ + (d ? (SEQ - 1 - pl) : pl);
}
__device__ __forceinline__ void p5_prefix_and_summaries(Frame& F) {
    {
        const bf16_t* SL = (const bf16_t*)(F.ws + WS_SLOC); bf16_t* BC = (bf16_t*)(F.ws + WS_BCAT);
        for (int it = F.bid * 512 + F.tid; it < 128 * 8192; it += F.G * 512) {
            const int bhd = it >> 13, el = (it & 8191) * 8, bh = bhd >> 1, dir = bhd & 1, h = bh & 3, e = el >> 8, d = el & 255;
            const float cd = fexp2(256.0f * l2gamma(h));
            const bf16_t* sl = SL + (size_t)bhd * 9 * 65536 + el;
            float s[8]; unpack8(*(const u32x4*)sl, s);
#pragma unroll
            for (int st = 0; st < 8; ++st) { const int c = dir ? 7 - st : st;
                *(u32x4*)(BC + ((size_t)(bh * 8 + c) * 256 + e) * 768 + 256 + dir * 256 + d) = pack8(s);
                if (st < 7) { float x[8]; unpack8(*(const u32x4*)(sl + (size_t)(c + 1) * 65536), x);
#pragma unroll
                    for (int q = 0; q < 8; ++q) s[q] = s[q] * cd + x[q]; } }
        }
    }
    {
        const bf16_t* G = (const bf16_t*)(F.ws + WS_G); const bf16_t* U = (const bf16_t*)(F.ws + WS_U); const float* k8 = (const float*)(F.ws + WS_C8SP);
        float* SA = (float*)(F.ws + WS_SUMA); float* SB = (float*)(F.ws + WS_SUMB);
        const int ch = 2 * F.tid, blk = ch >> 7, cj = ch & 127;
        for (int it = F.bid; it < NB * 2 * NLCH; it += F.G) {
            const int ck = it % NLCH, bd = it / NLCH, d = bd & 1, b = bd >> 1;
            LruCh P; P.ba0 = INP(IN_LBA)[d * DL + ch]; P.ba1 = INP(IN_LBA)[d * DL + ch + 1]; P.bx0 = INP(IN_LBX)[d * DL + ch]; P.bx1 = INP(IN_LBX)[d * DL + ch + 1];
            P.k0 = k8[d * DL + ch]; P.k1 = k8[d * DL + ch + 1];
            const int gcol = blk * 512 + d * 256 + cj;
            float A0 = 1.f, A1 = 1.f, B0 = 0.f, B1 = 0.f;
#pragma unroll 8
            for (int t = 0; t < LCH; ++t) { const int row = lru_row(b, d, ck * LCH + t);
                const unsigned rw = *(const unsigned*)(G + (size_t)row * 4096 + gcol), iw = *(const unsigned*)(G + (size_t)row * 4096 + gcol + 128), uw = *(const unsigned*)(U + (size_t)row * 1024 + ch);
                float a0, b0, a1, b1; lru_ab(P, rw, iw, uw, a0, b0, a1, b1);
                A0 *= a0; A1 *= a1; B0 = a0 * B0 + b0; B1 = a1 * B1 + b1; }
            const size_t o = ((size_t)bd * NLCH + ck) * DL + ch;
            *(f32x2*)(SA + o) = (f32x2){A0, A1}; *(f32x2*)(SB + o) = (f32x2){B0, B1};
        }
    }
}
__device__ __forceinline__ void p6_carries(Frame& F) {
    const float* SA = (const float*)(F.ws + WS_SUMA); const float* SB = (const float*)(F.ws + WS_SUMB); float* CI = (float*)(F.ws + WS_CIN);
    for (int it = F.bid * 512 + F.tid; it < NB * 2 * DL; it += F.G * 512) {
        const int bd = it >> 10, ch = it & 1023; float h = 0.f;
#pragma unroll 8
        for (int ck = 0; ck < NLCH; ++ck) { const size_t o = ((size_t)bd * NLCH + ck) * DL + ch; CI[o] = h; h = SA[o] * h + SB[o]; }
    }
}
__device__ __forceinline__ float gelu_tanh(float y) { const float t = 0.7978845608f * (y + 0.044715f * y * y * y); const float e = fexp(2.0f * t); return 0.5f * y * (2.0f - 2.0f * frcp(e + 1.0f)); }
__device__ __forceinline__ void p7_merge(Frame& F) {
    bf16_t* MRG = (bf16_t*)(F.ws + WS_MRG);
    {
        const bf16_t* O = (const bf16_t*)(F.ws + WS_O); const bf16_t* GT = (const bf16_t*)(F.ws + WS_GT); const float* rng = INP(IN_RNG);
        for (int it = F.bid * 8 + F.wave; it < NL * 4; it += F.G * 8) {
            const int row = it >> 2, h = it & 3; const size_t off = (size_t)row * 1024 + h * 256 + 4 * F.lane;
            const u32x2 ow = *(const u32x2*)(O + off), gw = *(const u32x2*)(GT + off);
            const float o0 = bf_lo(ow.x), o1 = bf_hi(ow.x), o2 = bf_lo(ow.y), o3 = bf_hi(ow.y);
            const float mu = wave_sum((o0 + o1) + (o2 + o3)) * (1.0f / 256.0f);
            const float d0 = o0 - mu, d1 = o1 - mu, d2 = o2 - mu, d3 = o3 - mu;
            const float rstd = 1.0f / sqrtf(wave_sum((d0 * d0 + d1 * d1) + (d2 * d2 + d3 * d3)) * (1.0f / 256.0f) + EPS);
            const f32x4 gn = *(const f32x4*)(rng + h * 256 + 4 * F.lane);
            const float g0 = bf_lo(gw.x), g1 = bf_hi(gw.x), g2 = bf_lo(gw.y), g3 = bf_hi(gw.y);
            u32x2 w; w.x = cvt_pk_bf16(d0 * rstd * gn.x * g0 * fsigmoid(g0), d1 * rstd * gn.y * g1 * fsigmoid(g1)); w.y = cvt_pk_bf16(d2 * rstd * gn.z * g2 * fsigmoid(g2), d3 * rstd * gn.w * g3 * fsigmoid(g3));
            *(u32x2*)(MRG + (size_t)row * DM + h * 256 + 4 * F.lane) = w;
        }
    }
    {
        const bf16_t* G = (const bf16_t*)(F.ws + WS_G); const bf16_t* U = (const bf16_t*)(F.ws + WS_U); const bf16_t* YB = (const bf16_t*)(F.ws + WS_YB);
        const float* k8 = (const float*)(F.ws + WS_C8SP); const float* CI = (const float*)(F.ws + WS_CIN); const float* lng = INP(IN_LNG);
        LAS float* red = (LAS float*)(F.lds + LDS_MISC);
        LAS f32x2* hfl = (LAS f32x2*)F.lds + F.tid;
        const int ch = 2 * F.tid, blk = ch >> 7, cj = ch & 127;
        for (int it = F.bid; it < NB * (SEQ / LCH); it += F.G) {
            const int b = it >> 6, lc = it & 63; const int row0 = b * SEQ + lc * LCH;
            {
                LruCh P; P.ba0 = INP(IN_LBA)[ch]; P.ba1 = INP(IN_LBA)[ch + 1]; P.bx0 = INP(IN_LBX)[ch]; P.bx1 = INP(IN_LBX)[ch + 1]; P.k0 = k8[ch]; P.k1 = k8[ch + 1];
                const f32x2 ci = *(const f32x2*)(CI + ((size_t)(b * 2 + 0) * NLCH + 8 + lc) * DL + ch); float h0 = ci.x, h1 = ci.y;
                const bf16_t* gp = G + (size_t)row0 * 4096 + blk * 512 + cj; const bf16_t* up = U + (size_t)row0 * 1024 + ch;
#pragma unroll 4
                for (int t = 0; t < LCH; ++t) {
                    const unsigned rw = *(const unsigned*)(gp + (size_t)t * 4096), iw = *(const unsigned*)(gp + (size_t)t * 4096 + 128), uw = *(const unsigned*)(up + (size_t)t * 1024);
                    float a0, b0, a1, b1; lru_ab(P, rw, iw, uw, a0, b0, a1, b1);
                    h0 = a0 * h0 + b0; h1 = a1 * h1 + b1; hfl[t * 512] = (f32x2){h0, h1}; }
            }
            {
                LruCh P; P.ba0 = INP(IN_LBA)[DL + ch]; P.ba1 = INP(IN_LBA)[DL + ch + 1]; P.bx0 = INP(IN_LBX)[DL + ch]; P.bx1 = INP(IN_LBX)[DL + ch + 1]; P.k0 = k8[DL + ch]; P.k1 = k8[DL + ch + 1];
                const f32x2 ci = *(const f32x2*)(CI + ((size_t)(b * 2 + 1) * NLCH + 8 + (63 - lc)) * DL + ch); float h0 = ci.x, h1 = ci.y;
                const bf16_t* gp = G + (size_t)row0 * 4096 + blk * 512 + 256 + cj; const bf16_t* up = U + (size_t)row0 * 1024 + ch; const bf16_t* yp = YB + (size_t)row0 * 1024 + ch;
#pragma unroll 4
                for (int t = LCH - 1; t >= 0; --t) {
                    const unsigned rw = *(const unsigned*)(gp + (size_t)t * 4096), iw = *(const unsigned*)(gp + (size_t)t * 4096 + 128), uw = *(const unsigned*)(up + (size_t)t * 1024);
                    float a0, b0, a1, b1; lru_ab(P, rw, iw, uw, a0, b0, a1, b1);
                    h0 = a0 * h0 + b0; h1 = a1 * h1 + b1;
                    const unsigned yw = *(const unsigned*)(yp + (size_t)t * 1024); const f32x2 hf = hfl[t * 512];
                    const float w0 = (hf.x + h0) * gelu_tanh(bf_lo(yw)), w1 = (hf.y + h1) * gelu_tanh(bf_hi(yw));
                    hfl[t * 512] = (f32x2){w0, w1};
                    const float sq = wave_sum(w0 * w0 + w1 * w1); if (F.lane == 0) red[F.wave * LCH + t] = sq; }
            }
            __syncthreads();
            const f32x2 gn = *(const f32x2*)(lng + ch);
#pragma unroll 4
            for (int t = 0; t < LCH; ++t) { float sq = 0.f;
#pragma unroll
                for (int w = 0; w < 8; ++w) sq += red[w * LCH + t];
                const float rstd = 1.0f / sqrtf(sq * (1.0f / DL) + EPS); const f32x2 v = hfl[t * 512];
                *(unsigned*)(MRG + (size_t)(row0 + t) * DM + DR + ch) = cvt_pk_bf16(v.x * rstd * gn.x, v.y * rstd * gn.y); }
            __syncthreads();
        }
    }
}
__device__ __forceinline__ void p9_router(Frame& F) {
    const float* X1 = F.out; const float* mod = (const float*)(F.ws + WS_MOD); const float* n2g = INP(IN_N2G); const float* rwT = (const float*)(F.ws + WS_RWT); const float* rb = INP(IN_RB);
    bf16_t* H2 = (bf16_t*)(F.ws + WS_H2); int* topi = (int*)(F.ws + WS_TOPI); float* topg = (float*)(F.ws + WS_TOPG); int* cnt16 = (int*)(F.ws + WS_CNT16);
    LAS float* lgs = (LAS float*)(F.lds + F.wave * 16384); LAS int* ids = (LAS int*)(F.lds + F.wave * 16384 + 4096);
    const int rl = F.lane & 15, kq = F.lane >> 4;
    for (int g = F.bid * 8 + F.wave; g < NL / 16; g += F.G * 8) {
        const int tok = g * 16 + rl, b = tok >> 11;
        const f32x4* xp = (const f32x4*)(X1 + (size_t)tok * DM) + kq;
        float s = 0.f;
#pragma unroll 8
        for (int q = 0; q < 128; ++q) { const f32x4 x = xp[4 * q]; s += (x.x * x.x + x.y * x.y) + (x.z * x.z + x.w * x.w); }
        s += __shfl_xor(s, 16); s += __shfl_xor(s, 32);
        const float rstd = 1.0f / sqrtf(s * (1.0f / DM) + EPS);
        const f32x4* gp = (const f32x4*)n2g + kq; const f32x4* shp = (const f32x4*)(mod + (size_t)b * MODW + 3 * DM) + kq; const f32x4* scp = (const f32x4*)(mod + (size_t)b * MODW + 4 * DM) + kq;
        const f32x4* w0p = (const f32x4*)(rwT + (size_t)rl * DM) + kq; const f32x4* w1p = (const f32x4*)(rwT + (size_t)(16 + rl) * DM) + kq;
        u32x2* hp = (u32x2*)(H2 + (size_t)tok * DM) + kq;
        f32x4 acc0 = (f32x4){0.f, 0.f, 0.f, 0.f}, acc1 = (f32x4){0.f, 0.f, 0.f, 0.f};
#pragma unroll 4
        for (int q = 0; q < 128; ++q) {
            const f32x4 x = xp[4 * q], gg = gp[4 * q], sh = shp[4 * q], sc = scp[4 * q], w0 = w0p[4 * q], w1 = w1p[4 * q];
            const f32x4 h = x * rstd * gg * (1.0f + sc) + sh;
            u32x2 hw; hw.x = cvt_pk_bf16(h.x, h.y); hw.y = cvt_pk_bf16(h.z, h.w); hp[4 * q] = hw;
            acc0 = __builtin_amdgcn_mfma_f32_16x16x4f32(h.x, w0.x, acc0, 0, 0, 0); acc1 = __builtin_amdgcn_mfma_f32_16x16x4f32(h.x, w1.x, acc1, 0, 0, 0);
            acc0 = __builtin_amdgcn_mfma_f32_16x16x4f32(h.y, w0.y, acc0, 0, 0, 0); acc1 = __builtin_amdgcn_mfma_f32_16x16x4f32(h.y, w1.y, acc1, 0, 0, 0);
            acc0 = __builtin_amdgcn_mfma_f32_16x16x4f32(h.z, w0.z, acc0, 0, 0, 0); acc1 = __builtin_amdgcn_mfma_f32_16x16x4f32(h.z, w1.z, acc1, 0, 0, 0);
            acc0 = __builtin_amdgcn_mfma_f32_16x16x4f32(h.w, w0.w, acc0, 0, 0, 0); acc1 = __builtin_amdgcn_mfma_f32_16x16x4f32(h.w, w1.w, acc1, 0, 0, 0);
        }
        const float rb0 = rb[rl], rb1 = rb[16 + rl];
#pragma unroll
        for (int j = 0; j < 4; ++j) { lgs[(4 * kq + j) * 33 + rl] = acc0[j] + rb0; lgs[(4 * kq + j) * 33 + 16 + rl] = acc1[j] + rb1; }
        LDS_WAIT(); asm volatile("" ::: "memory");
        if (F.lane < 16) {
            float v0 = -3.0e38f, v1 = -3.0e38f, v2 = -3.0e38f, v3 = -3.0e38f; int i0 = 0, i1 = 0, i2 = 0, i3 = 0;
#pragma unroll
            for (int e = 0; e < NE; ++e) { float x = lgs[F.lane * 33 + e]; int xi = e;
                if (x > v0) { const float tv = v0; const int ti = i0; v0 = x; i0 = xi; x = tv; xi = ti; }
                if (x > v1) { const float tv = v1; const int ti = i1; v1 = x; i1 = xi; x = tv; xi = ti; }
                if (x > v2) { const float tv = v2; const int ti = i2; v2 = x; i2 = xi; x = tv; xi = ti; }
                if (x > v3) { v3 = x; i3 = xi; } }
            const float e1 = fexp(v1 - v0), e2 = fexp(v2 - v0), e3 = fexp(v3 - v0); const float inv = 1.0f / (1.0f + e1 + e2 + e3);
            const int t2 = g * 16 + F.lane;
            *(int4*)(topi + (size_t)t2 * 4) = make_int4(i0, i1, i2, i3); *(f32x4*)(topg + (size_t)t2 * 4) = (f32x4){inv, e1 * inv, e2 * inv, e3 * inv};
            ids[F.lane * 4 + 0] = i0; ids[F.lane * 4 + 1] = i1; ids[F.lane * 4 + 2] = i2; ids[F.lane * 4 + 3] = i3;
        }
        LDS_WAIT(); asm volatile("" ::: "memory");
        if (F.lane < NE) { int c = 0;
#pragma unroll 16
            for (int q = 0; q < 64; ++q) c += (ids[q] == F.lane) ? 1 : 0;
            cnt16[(size_t)g * NE + F.lane] = c; }
        LDS_WAIT(); asm volatile("" ::: "memory");
    }
}
__device__ __forceinline__ void p10_routing(Frame& F) {
    const int* cnt16 = (const int*)(F.ws + WS_CNT16); const int* topi = (const int*)(F.ws + WS_TOPI); const float* topg = (const float*)(F.ws + WS_TOPG);
    int* tokslot = (int*)(F.ws + WS_TOKSLOT); float* gateslot = (float*)(F.ws + WS_GATESLOT); int* slotof = (int*)(F.ws + WS_SLOTOF); int* tile_e = (int*)(F.ws + WS_TILEE);
    LAS int* L = (LAS int*)(F.lds);
    for (int seg = F.bid; seg < 256; seg += F.G) {
        { const int e = F.tid & 31, part = F.tid >> 5; int tot = 0, pre = 0;
#pragma unroll 1
          for (int s = part * 16; s < part * 16 + 16; ++s) { int ss = 0;
#pragma unroll 2
              for (int gi = 0; gi < 8; ++gi) ss += cnt16[(size_t)(8 * s + gi) * NE + e];
              tot += ss; if (s < seg) pre += ss; }
          L[part * 32 + e] = tot; L[512 + part * 32 + e] = pre; }
        __syncthreads();
        if (F.tid < 32) { int tot = 0, pre = 0;
#pragma unroll
            for (int p = 0; p < 16; ++p) { tot += L[p * 32 + F.tid]; pre += L[512 + p * 32 + F.tid]; }
            L[1024 + F.tid] = tot; L[1056 + F.tid] = (tot + 255) & ~255; L[1088 + F.tid] = pre; }
        __syncthreads();
        if (F.tid < 32) { int base = 0; for (int e = 0; e < 32; ++e) base += (e < F.tid) ? L[1056 + e] : 0; L[1120 + F.tid] = base; }
        __syncthreads();
        {
            const int g = 8 * seg + F.wave; LAS int* offs = L + 2048 + F.wave * 128; LAS int* ids = offs + 32;
            if (F.lane < 32) { int o = L[1120 + F.lane] + L[1088 + F.lane]; for (int gj = 0; gj < F.wave; ++gj) o += cnt16[(size_t)(8 * seg + gj) * NE + F.lane]; offs[F.lane] = o; }
            int4 my = make_int4(0, 0, 0, 0); f32x4 mg = (f32x4){0.f, 0.f, 0.f, 0.f}; const int tok = g * 16 + (F.lane & 15);
            if (F.lane < 16) { my = *(const int4*)(topi + (size_t)tok * 4); mg = *(const f32x4*)(topg + (size_t)tok * 4);
                ids[F.lane * 4 + 0] = my.x; ids[F.lane * 4 + 1] = my.y; ids[F.lane * 4 + 2] = my.z; ids[F.lane * 4 + 3] = my.w; }
            LDS_WAIT(); asm volatile("" ::: "memory");
            if (F.lane < 16) { int r0 = 0, r1 = 0, r2 = 0, r3 = 0;
                for (int t2 = 0; t2 < 16; ++t2) { if (t2 < F.lane) {
#pragma unroll
                        for (int k = 0; k < 4; ++k) { const int x = ids[t2 * 4 + k]; r0 += (x == my.x); r1 += (x == my.y); r2 += (x == my.z); r3 += (x == my.w); } } }
                const int s0 = offs[my.x] + r0, s1 = offs[my.y] + r1, s2 = offs[my.z] + r2, s3 = offs[my.w] + r3;
                tokslot[s0] = tok; tokslot[s1] = tok; tokslot[s2] = tok; tokslot[s3] = tok;
                gateslot[s0] = mg.x; gateslot[s1] = mg.y; gateslot[s2] = mg.z; gateslot[s3] = mg.w;
                *(int4*)(slotof + (size_t)tok * 4) = make_int4(s0, s1, s2, s3); }
        }
        if (seg < 32) { const int beg = L[1120 + seg] + L[1024 + seg], end = L[1120 + seg] + L[1056 + seg];
            for (int s = beg + F.tid; s < end; s += 512) { tokslot[s] = 0; gateslot[s] = 0.f; } }
        if (seg == 0) { const int ntl = (L[1120 + 31] + L[1056 + 31]) >> 8;
            for (int mt = F.tid; mt < ntl; mt += 512) { int e = 0;
                for (int q = 0; q < 32; ++q) { const int lo = L[1120 + q] >> 8, hi = (L[1120 + q] + L[1056 + q]) >> 8; if (mt >= lo && mt < hi) e = q; }
                tile_e[mt] = e; }
            if (F.tid == 0) tile_e[1024] = ntl; }
        __syncthreads();
    }
}
__device__ __forceinline__ void p13_final(Frame& F) {
    const float* mod = (const float*)(F.ws + WS_MOD); const bf16_t* Y = (const bf16_t*)(F.ws + WS_Y); const int* slotof = (const int*)(F.ws + WS_SLOTOF); const float* fng = INP(IN_FNG);
    for (int row = F.bid * 8 + F.wave; row < NL; row += F.G * 8) {
        const int b = row >> 11; const int4 sl = *(const int4*)(slotof + (size_t)row * 4);
        f32x4* xp = (f32x4*)(F.out + (size_t)row * DM) + F.lane; const f32x4* g2p = (const f32x4*)(mod + (size_t)b * MODW + 5 * DM) + F.lane;
        const u32x2* y0 = (const u32x2*)(Y + (size_t)sl.x * DM) + F.lane; const u32x2* y1 = (const u32x2*)(Y + (size_t)sl.y * DM) + F.lane;
        const u32x2* y2 = (const u32x2*)(Y + (size_t)sl.z * DM) + F.lane; const u32x2* y3 = (const u32x2*)(Y + (size_t)sl.w * DM) + F.lane;
        f32x4 v[8]; float s = 0.f;
#pragma unroll
        for (int j = 0; j < 8; ++j) { const u32x2 a = y0[64 * j], bq = y1[64 * j], c = y2[64 * j], d = y3[64 * j]; const f32x4 g2 = g2p[64 * j];
            f32x4 m; m.x = (bf_lo(a.x) + bf_lo(bq.x)) + (bf_lo(c.x) + bf_lo(d.x)); m.y = (bf_hi(a.x) + bf_hi(bq.x)) + (bf_hi(c.x) + bf_hi(d.x));
            m.z = (bf_lo(a.y) + bf_lo(bq.y)) + (bf_lo(c.y) + bf_lo(d.y)); m.w = (bf_hi(a.y) + bf_hi(bq.y)) + (bf_hi(c.y) + bf_hi(d.y));
            v[j] = xp[64 * j] + g2 * m; s += (v[j].x * v[j].x + v[j].y * v[j].y) + (v[j].z * v[j].z + v[j].w * v[j].w); }
        const float rstd = 1.0f / sqrtf(wave_sum(s) * (1.0f / DM) + EPS);
        const f32x4* fp = (const f32x4*)fng + F.lane;
#pragma unroll
        for (int j = 0; j < 8; ++j) xp[64 * j] = v[j] * rstd * fp[64 * j];
    }
}

constexpr int N_PHASES = 15;
__global__ void __launch_bounds__(512, 2) mk_fwd(Args args) {
    extern __shared__ __attribute__((aligned(16))) unsigned char lds_raw[];
    Frame F;
    F.lds = (LAS unsigned char*)lds_raw; F.ws = args.ws; F.out = args.out; F.in = args.in;
    F.tid = threadIdx.x; F.lane = F.tid & 63; F.wave = __builtin_amdgcn_readfirstlane(F.tid >> 6); F.G = gridDim.x; F.bid = blockIdx.x;
    volatile LAS unsigned* MISC = (volatile LAS unsigned*)(F.lds + LDS_MISC + 4096);
    if (F.tid < 64) MISC[F.tid] = 0u;
    __syncthreads();
    const int lo = args.ph_lo, hi = args.ph_hi;
    XcdBarrier bar; bar.bar = (unsigned*)(args.ws + WS_CTL) + CW_BAR; bar.x = 0; bar.st = nullptr;
    if (hi - lo > 1) bar = xcd_barrier_post((unsigned*)(args.ws + WS_CTL) + CW_BAR, MISC);
#ifndef ONLY_PH
#define ONLY_PH -1
#endif
#define IN(k) (lo <= (k) && (k) < hi && (ONLY_PH < 0 || ONLY_PH == (k)))
#define SEAM(k) do { if (IN(k) && IN((k) + 1)) xcd_barrier(bar); } while (0)
    LAS unsigned char* ring = F.lds;

    if (IN(0)) { p0_prologue(F); } SEAM(0);
    if (IN(1)) { p0b_mod(F); } SEAM(1);
    if (IN(2)) { p1_norm1(F); } SEAM(2);
    if (IN(3)) { Sched<K_INPROJ> S{F.G, F.bid, F.ws, (unsigned char*)F.out}; EpiPlain E; pg8::gemm_phase<EpiPlain, Sched<K_INPROJ>, false>(ring, pg8::Cfg{DM, DM, 32}, S, E); } SEAM(3);
    if (IN(4)) { p3_prep(F); } SEAM(4);
    if (IN(5)) {
        { Sched<K_SCORES> S{F.G, F.bid, F.ws, (unsigned char*)F.out}; EpiScores E; pg8::gemm_phase<EpiScores, Sched<K_SCORES>, false>(ring, pg8::Cfg{768, 1024, 4}, S, E); }
        { Sched<K_STATE> S{F.G, F.bid, F.ws, (unsigned char*)F.out}; EpiPlain E; pg8::gemm_phase<EpiPlain, Sched<K_STATE>, false>(ring, pg8::Cfg{768, NT, 4}, S, E); }
        { Sched<K_GATES> S{F.G, F.bid, F.ws, (unsigned char*)F.out}; EpiPlain E; pg8::gemm_phase<EpiPlain, Sched<K_GATES>, false>(ring, pg8::Cfg{1024, 128, 2}, S, E); }
    } SEAM(5);
    if (IN(6)) { p5_prefix_and_summaries(F); } SEAM(6);
    if (IN(7)) { p6_carries(F);
        { Sched<K_R3> S{F.G, F.bid, F.ws, (unsigned char*)F.out}; EpiPlain E; pg8::gemm_phase<EpiPlain, Sched<K_R3>, false>(ring, pg8::Cfg{768, 768, 12}, S, E); } } SEAM(7);
    if (IN(8)) { p7_merge(F); } SEAM(8);
    if (IN(9)) { Sched<K_OUT> S{F.G, F.bid, F.ws, (unsigned char*)F.out}; EpiOut E{INP(IN_X), (const float*)(F.ws + WS_MOD), F.out}; pg8::gemm_phase<EpiOut, Sched<K_OUT>, false>(ring, pg8::Cfg{DM, DM, 32}, S, E); } SEAM(9);
    if (IN(10)) { p9_router(F); } SEAM(10);
    if (IN(11)) { p10_routing(F); } SEAM(11);
    if (IN(12)) { Sched<K_MOE1> S{F.G, F.bid, F.ws, (unsigned char*)F.out}; EpiSwiGLU E{INP(IN_BG), INP(IN_BU)}; pg8::gemm_phase<EpiSwiGLU, Sched<K_MOE1>, true>(ring, pg8::Cfg{DM, DM, 32}, S, E); } SEAM(12);
    if (IN(13)) { Sched<K_MOE2> S{F.G, F.bid, F.ws, (unsigned char*)F.out}; EpiDown E{INP(IN_BD), (const float*)(F.ws + WS_GATESLOT)}; pg8::gemm_phase<EpiDown, Sched<K_MOE2>, false>(ring, pg8::Cfg{DM, DM, 32}, S, E); } SEAM(13);
    if (IN(14)) { p13_final(F); }
#undef IN
#undef SEAM
}

extern "C" void kernel_launch(void* const* d_in, const int* in_sizes, int n_in, void* d_out, int out_size, void* d_ws, size_t ws_size, hipStream_t stream) {
    static int grid = 0;
    if (grid == 0) {
        if (n_in != 28 || out_size != NL * DM || ws_size < WS_END) { fprintf(stderr, "kernel_launch: unexpected shapes (n_in %d, out %d, ws %zu); nothing launched\n", n_in, out_size, ws_size); grid = -1; return; }
        int dev = 0, cus = 0, per_cu = 0;
        if (hipGetDevice(&dev) != hipSuccess || hipDeviceGetAttribute(&cus, hipDeviceAttributeMultiprocessorCount, dev) != hipSuccess) { grid = -1; return; }
        if (hipFuncSetAttribute((const void*)mk_fwd, hipFuncAttributeMaxDynamicSharedMemorySize, LDS_BYTES) != hipSuccess) { fprintf(stderr, "kernel_launch: hipFuncSetAttribute failed\n"); grid = -1; return; }
        if (hipOccupancyMaxActiveBlocksPerMultiprocessor(&per_cu, (const void*)mk_fwd, 512, LDS_BYTES) != hipSuccess || per_cu < 1) fprintf(stderr, "kernel_launch: occupancy query reports %d blocks per CU\n", per_cu);
        (void)hipGetLastError();
        grid = cus;
    }
    if (grid < 0) return;
    if (hipMemsetAsync((char*)d_ws + WS_CTL, 0, 131072, stream) != hipSuccess) return;
    Args a{};
    for (int i = 0; i < 28; ++i) a.in[i] = (const float*)d_in[i];
    a.out = (float*)d_out; a.ws = (unsigned char*)d_ws; a.pad = 0;
#if MK_MULTI
    for (int p = 0; p < N_PHASES; ++p) { a.ph_lo = p; a.ph_hi = p + 1; a.li = p; hipLaunchKernelGGL(mk_fwd, dim3(grid), dim3(512), LDS_BYTES, stream, a); }
#else
    a.ph_lo = 0; a.ph_hi = N_PHASES; a.li = 0;
    hipLaunchKernelGGL(mk_fwd, dim3(grid), dim3(512), LDS_BYTES, stream, a);
#endif
}
```

```cpp
#include <hip/hip_runtime.h>
#include <cstdio>
#include <cstdint>

#ifndef MK_MULTI
#define MK_MULTI 0
#endif

#define LAS __attribute__((address_space(3)))
#define GAS __attribute__((address_space(1)))
typedef unsigned short bf16_t;
typedef short bf16x8 __attribute__((ext_vector_type(8)));
typedef float f32x4 __attribute__((ext_vector_type(4)));
typedef float f32x2 __attribute__((ext_vector_type(2)));
typedef unsigned u32x4 __attribute__((ext_vector_type(4)));
typedef unsigned u32x2 __attribute__((ext_vector_type(2)));

constexpr int DM = 2048, NB = 16, SEQ = 2048, NCTX = 256;
constexpr int NL = NB * SEQ;
constexpr int NCT = NB * NCTX;
constexpr int NT = NL + NCT;
constexpr int NH = 4, HD = 256, DR = 1024, DL = 1024, DIN = 6144, NE = 32, TOPK = 4;
constexpr int PMAX = 139264;
constexpr int MODW = 6 * DM;
constexpr int LCH = 32, NLCH = (NCTX + SEQ) / LCH;
constexpr float EPS = 1e-6f;

constexpr size_t MiB = 1ull << 20;
constexpr size_t WS_CTL = 0;
constexpr size_t WS_MODP = 1 * MiB;
constexpr size_t WS_MOD = 8 * MiB;
constexpr size_t WS_CS = 9 * MiB;
constexpr size_t WS_RWT = WS_CS + 64 * 1024;
constexpr size_t WS_C8SP = WS_RWT + 256 * 1024;
constexpr size_t WS_TOPI = 10 * MiB;
constexpr size_t WS_TOPG = WS_TOPI + 512 * 1024;
constexpr size_t WS_CNT16 = WS_TOPG + 512 * 1024;
constexpr size_t WS_TOKSLOT = 12 * MiB;
constexpr size_t WS_GATESLOT = WS_TOKSLOT + 1 * MiB;
constexpr size_t WS_SLOTOF = WS_GATESLOT + 1 * MiB;
constexpr size_t WS_TILEE = WS_SLOTOF + 1 * MiB;
constexpr size_t WS_WINT = 16 * MiB;
constexpr size_t WS_WOT = 40 * MiB;
constexpr size_t WS_LRUBT = 48 * MiB;
constexpr size_t WS_WD = 64 * MiB;
constexpr size_t WS_WG = 320 * MiB;
constexpr size_t WS_WU = 576 * MiB;
constexpr size_t DYN = 832 * MiB;
constexpr size_t WS_HX = DYN;
constexpr size_t WS_Q = DYN + 144 * MiB;
constexpr size_t WS_KT = WS_Q + 64 * MiB;
constexpr size_t WS_KTR = WS_KT + 64 * MiB;
constexpr size_t WS_URAW = WS_KTR + 72 * MiB;
constexpr size_t WS_GT = WS_URAW + 72 * MiB;
constexpr size_t WS_YB = WS_GT + 64 * MiB;
constexpr size_t WS_BCAT = WS_YB + 64 * MiB;
constexpr size_t WS_VTC = WS_BCAT + 192 * MiB;
constexpr size_t WS_KR = WS_VTC + 24 * MiB;
constexpr size_t WS_KDF = WS_KR + 64 * MiB;
constexpr size_t WS_KDB = WS_KDF + 72 * MiB;
constexpr size_t WS_U = WS_KDB + 72 * MiB;
constexpr size_t WS_SLOC = WS_U + 72 * MiB;
constexpr size_t WS_SUMA = WS_SLOC + 144 * MiB;
constexpr size_t WS_SUMB = WS_SUMA + 9 * MiB;
constexpr size_t WS_CIN = WS_SUMB + 9 * MiB;
constexpr size_t WS_G = DYN;
constexpr size_t WS_O = DYN + 288 * MiB;
constexpr size_t WS_MRG = WS_KR;
constexpr size_t WS_H2 = DYN;
constexpr size_t WS_ACT = DYN + 128 * MiB;
constexpr size_t WS_Y = WS_ACT + 544 * MiB;
constexpr size_t WS_END = 2048 * MiB;
static_assert(WS_CIN + 9 * MiB <= WS_END && WS_Y + 544 * MiB <= WS_END && WS_G + 288 * MiB <= WS_KTR + 72 * MiB && WS_O + 64 * MiB <= WS_GT && WS_O >= WS_G + 288 * MiB && WS_MRG + 128 * MiB <= WS_KDB, "ws map");

constexpr int CW_BAR = 4096;
constexpr int LDS_RING = 131072, LDS_MISC = LDS_RING, LDS_BYTES = 147456;

__device__ __forceinline__ unsigned cvt_pk_bf16(float lo, float hi) { unsigned r; asm volatile("v_cvt_pk_bf16_f32 %0, %1, %2" : "=v"(r) : "v"(lo), "v"(hi)); return r; }
__device__ __forceinline__ float bf_lo(unsigned w) { return __uint_as_float(w << 16); }
__device__ __forceinline__ float bf_hi(unsigned w) { return __uint_as_float(w & 0xffff0000u); }
__device__ __forceinline__ void unpack8(const u32x4 w, float (&v)[8]) { v[0] = bf_lo(w.x); v[1] = bf_hi(w.x); v[2] = bf_lo(w.y); v[3] = bf_hi(w.y); v[4] = bf_lo(w.z); v[5] = bf_hi(w.z); v[6] = bf_lo(w.w); v[7] = bf_hi(w.w); }
__device__ __forceinline__ u32x4 pack8(const float (&v)[8]) { u32x4 w; w.x = cvt_pk_bf16(v[0], v[1]); w.y = cvt_pk_bf16(v[2], v[3]); w.z = cvt_pk_bf16(v[4], v[5]); w.w = cvt_pk_bf16(v[6], v[7]); return w; }
constexpr float W_SCALE = 32.0f, H2_SCALE = 4.0f, ACT_SCALE = 4.0f;
__device__ __forceinline__ unsigned pk4_fp8(float a, float b, float c, float d) { int w = __builtin_amdgcn_cvt_pk_fp8_f32(a, b, 0, false); w = __builtin_amdgcn_cvt_pk_fp8_f32(c, d, w, true); return (unsigned)w; }
__device__ __forceinline__ u32x2 pack8_fp8(const float (&v)[8]) { u32x2 w; w.x = pk4_fp8(v[0], v[1], v[2], v[3]); w.y = pk4_fp8(v[4], v[5], v[6], v[7]); return w; }
__device__ __forceinline__ float fexp2(float x) { return __builtin_amdgcn_exp2f(x); }
__device__ __forceinline__ float fexp(float x) { return __builtin_amdgcn_exp2f(x * 1.44269504089f); }
__device__ __forceinline__ float frcp(float x) { return __builtin_amdgcn_rcpf(x); }
__device__ __forceinline__ float fsigmoid(float x) { return frcp(1.0f + fexp(-x)); }
__device__ __forceinline__ float wave_sum(float v) {
#pragma unroll
    for (int o = 1; o < 64; o <<= 1) v += __shfl_xor(v, o);
    return v;
}
#define LDS_WAIT() asm volatile("s_waitcnt lgkmcnt(0)" ::: "memory")
#define VM_WAIT() asm volatile("s_waitcnt vmcnt(0)" ::: "memory")
__device__ __forceinline__ float l2gamma(int h) { return h == 0 ? -0.0458036896f : (h == 1 ? -0.0227200765f : (h == 2 ? -0.0113153091f : -0.0056465633f)); }

#define XB_TMO      128
#define XB_XCNT(j)  (256  + 64 * (j))
#define XB_XSUB(j)  (1280 + 64 * (j))
#define XB_XGEN(j)  (2304 + 64 * (j))
#define XB_TOP      3328
#define XB_TOPGEN   3392
#define XCD_BAR_WORDS 3456
#define XB_SPIN_CAP (1u << 18)
__device__ __forceinline__ unsigned xb_ld(unsigned* p)              { return __hip_atomic_load(p, __ATOMIC_RELAXED, __HIP_MEMORY_SCOPE_AGENT); }
__device__ __forceinline__ unsigned xb_add(unsigned* p, unsigned v) { return __hip_atomic_fetch_add(p, v, __ATOMIC_RELAXED, __HIP_MEMORY_SCOPE_AGENT); }
__device__ __forceinline__ unsigned xb_xcc_id() { return (unsigned)__builtin_amdgcn_s_getreg((3 << 11) | 20) & 0xFu; }
#define XB_SPIN(cond, bar) do { unsigned _sp = 0; while (cond) { __builtin_amdgcn_s_sleep(1); \
    if ((++_sp & 255u) == 0u) { if (xb_ld(&(bar)[XB_TMO])) break; if (_sp > XB_SPIN_CAP) { atomicAdd(&(bar)[XB_TMO], 1u); break; } } } } while (0)
struct XcdBarrier { unsigned* bar; unsigned x; volatile LAS unsigned* st; };
__device__ __forceinline__ XcdBarrier xcd_barrier_post(unsigned* bar, volatile LAS unsigned* st) {
    XcdBarrier b; b.bar = bar; b.x = xb_xcc_id(); b.st = st;
    if (threadIdx.x == 0) (void)xb_add(&bar[XB_XCNT(b.x)], 1u);
    return b;
}
__device__ __forceinline__ void xcd_barrier_complete(unsigned* bar, unsigned x, unsigned& nloc, unsigned& nx) {
    const unsigned G = gridDim.x * gridDim.y * gridDim.z;
    unsigned sum, cnt, mine, sp = 0u;
    for (;;) {
        sum = 0u; cnt = 0u; mine = 0u;
#pragma unroll
        for (unsigned j = 0; j < 16; ++j) { const unsigned c = xb_ld(&bar[XB_XCNT(j)]); sum += c; cnt += (c > 0u) ? 1u : 0u; mine = (j == x) ? c : mine; }
        if (sum == G) break;
        __builtin_amdgcn_s_sleep(1);
        if ((++sp & 255u) == 0u) { if (xb_ld(&bar[XB_TMO])) break; if (sp > XB_SPIN_CAP) { atomicAdd(&bar[XB_TMO], 1u); break; } }
    }
    nloc = mine > 0u ? mine : 1u; nx = cnt > 0u ? cnt : 1u;
}
__device__ __forceinline__ void xcd_barrier(const XcdBarrier& b) {
    asm volatile("s_waitcnt vmcnt(0)" ::: "memory");
    __syncthreads();
    if (threadIdx.x == 0) {
        unsigned* bar = b.bar;
        __builtin_amdgcn_s_waitcnt(0);
        unsigned nloc = b.st[0], nx = b.st[1];
        if (nloc == 0u) { xcd_barrier_complete(bar, b.x, nloc, nx); b.st[0] = nloc; b.st[1] = nx; }
        const unsigned old = xb_add(&bar[XB_XSUB(b.x)], 1u);
        const unsigned gen = old / nloc;
        if (old + 1u == (gen + 1u) * nloc) {
            __builtin_amdgcn_fence(__ATOMIC_RELEASE, "agent");
            asm volatile("s_waitcnt vmcnt(0)" ::: "memory");
            const unsigned og = xb_add(&bar[XB_TOP], 1u);
            const unsigned tg = og / nx;
            if (og + 1u == (tg + 1u) * nx) xb_add(&bar[XB_TOPGEN], 1u);
            else XB_SPIN(xb_ld(&bar[XB_TOPGEN]) == tg, bar);
            __builtin_amdgcn_fence(__ATOMIC_ACQUIRE, "agent");
            xb_add(&bar[XB_XGEN(b.x)], 1u);
            asm volatile("s_waitcnt vmcnt(0)" ::: "memory");
        } else {
            XB_SPIN(xb_ld(&bar[XB_XGEN(b.x)]) == gen, bar);
            __builtin_amdgcn_fence(__ATOMIC_ACQUIRE, "agent");
            asm volatile("s_waitcnt vmcnt(0)" ::: "memory");
        }
    }
    __syncthreads();
}

namespace pg8 {
constexpr int BM = 256, BK = 64, HALF = 128, HTB = HALF * BK * 2, STAGE_BYTES = 8 * HTB, NXCD = 8, WGM = 8;
__host__ __device__ __forceinline__ int lds_byte(int r, int c) { const int st = (r >> 4) * 2 + (c >> 5), rr = r & 15, cc = c & 31, ob = rr * 64 + cc * 2; return st * 1024 + (ob ^ (((ob >> 9) & 1) << 5)); }
__host__ __device__ __forceinline__ void stage_rc(int b, int& R, int& C) { const int st = b / 1024, sb = b % 1024, swz = sb ^ (((sb >> 9) & 1) << 5); R = (st >> 1) * 16 + swz / 64; C = (st & 1) * 32 + (swz % 64) / 2; }
__host__ __device__ __forceinline__ int perm32(int rho) { const int n = rho >> 4, i = rho & 15; return 8 * (i >> 2) + 4 * n + (i & 3); }

struct Unit { const char* a; const char* b0; const char* b1; char* out; const int* gidx; int ldc, r0, c0, e; };
struct Cfg { int lda, ldb, nt; };
typedef int i32x8 __attribute__((ext_vector_type(8)));
typedef int i32x4 __attribute__((ext_vector_type(4)));
typedef int i32x32 __attribute__((ext_vector_type(32)));

__device__ __forceinline__ void static_map(int L, int nM, int nN, int& pm, int& pn) {
    const int nwg = nM * nN; int wgid = L;
    { const int q = nwg / NXCD, r = nwg % NXCD, xcd = wgid % NXCD, off = wgid / NXCD; wgid = (xcd < r ? xcd * (q + 1) : r * (q + 1) + (xcd - r) * q) + off; }
    const int nig = WGM * nN, gid = wgid / nig, fm = gid * WGM, gsz = (nM - fm) < WGM ? (nM - fm) : WGM;
    pm = fm + ((wgid % nig) % gsz); pn = (wgid % nig) / gsz;
}

template <class Epi, class Sched, bool GATHER, bool FP8 = false>
__device__ __forceinline__ void gemm_phase(LAS unsigned char* lds, const Cfg g, const Sched& S, const Epi& E) {
    const int tid = threadIdx.x, wid = __builtin_amdgcn_readfirstlane(tid >> 6), lane = tid & 63, wr = wid >> 2, wc = wid & 3, fr = lane & 15, fq = lane >> 4;
    int nt = g.nt; asm volatile("" : "+s"(nt));
    int R0, C0, R1, C1; stage_rc(tid * 16, R0, C0); stage_rc(tid * 16 + 8192, R1, C1);
    const int Rb0 = Epi::PERM ? ((R0 & ~31) + perm32(R0 & 31)) : R0, Rb1 = Epi::PERM ? ((R1 & ~31) + perm32(R1 & 31)) : R1;
    const unsigned vB0 = (unsigned)(Rb0 * g.ldb + C0 * 2), vB1 = (unsigned)(Rb1 * g.ldb + C1 * 2);
    unsigned vA00, vA01, vA10, vA11;
    const size_t kstep = (size_t)(BK * 2);
    const size_t hstepA = (size_t)HALF * g.lda;
    const unsigned ldsw = (unsigned)wid * 1024u;
    const int aoff = lds_byte(wr * 64 + fr, fq * 8), boff = lds_byte(wc * 32 + fr, fq * 8);
#define PG8_SA(b, h) (((b) * 2 + (h)) * HTB)
#define PG8_SB(b, h) ((4 + (b) * 2 + (h)) * HTB)
#define PG8_STAGE(bufoff, gbase, v0, v1) do { const GAS char* _gb = (const GAS char*)(gbase); unsigned _v0 = (v0), _v1 = (v1); asm volatile("" : "+s"(_gb), "+v"(_v0), "+v"(_v1));     \
        __builtin_amdgcn_global_load_lds((const GAS unsigned*)(_gb + _v0), (LAS unsigned*)(lds + (bufoff) + ldsw), 16, 0, 0); \
        __builtin_amdgcn_global_load_lds((const GAS unsigned*)(_gb + _v1), (LAS unsigned*)(lds + (bufoff) + ldsw + 8192), 16, 0, 0); } while (0)
#define PG8_INS4(big, pos, addr) do { const i32x4 _v = *(const LAS i32x4*)(addr); big[(pos) + 0] = _v.x; big[(pos) + 1] = _v.y; big[(pos) + 2] = _v.z; big[(pos) + 3] = _v.w; } while (0)
#define PG8_SUB8(big, pos) __builtin_shufflevector(big, big, (pos), (pos) + 1, (pos) + 2, (pos) + 3, (pos) + 4, (pos) + 5, (pos) + 6, (pos) + 7)
#define PG8_LDA(dst, b, h) do { if constexpr (FP8) { _Pragma("unroll") for (int m = 0; m < 4; ++m) { PG8_INS4(A32, 8 * m, lds + PG8_SA(b, h) + aoff + m * 2048); PG8_INS4(A32, 8 * m + 4, lds + PG8_SA(b, h) + aoff + m * 2048 + 1024); } } \
        else { _Pragma("unroll") for (int m = 0; m < 4; ++m) _Pragma("unroll") for (int k = 0; k < 2; ++k) dst[m][k] = *(const LAS bf16x8*)(lds + PG8_SA(b, h) + aoff + m * 2048 + k * 1024); } } while (0)
#define PG8_LDB(dst, b, h) do { if constexpr (FP8) { _Pragma("unroll") for (int n = 0; n < 2; ++n) { PG8_INS4(B32, dst##_P + 8 * n, lds + PG8_SB(b, h) + boff + n * 2048); PG8_INS4(B32, dst##_P + 8 * n + 4, lds + PG8_SB(b, h) + boff + n * 2048 + 1024); } } \
        else { _Pragma("unroll") for (int n = 0; n < 2; ++n) _Pragma("unroll") for (int k = 0; k < 2; ++k) dst[n][k] = *(const LAS bf16x8*)(lds + PG8_SB(b, h) + boff + n * 2048 + k * 1024); } } while (0)
#define PG8_M8(ai, bj, m, n, BP) acc[ai][bj][m][n] = __builtin_amdgcn_mfma_scale_f32_16x16x128_f8f6f4(PG8_SUB8(B32, (BP) + 8 * (n)), PG8_SUB8(A32, 8 * (m)), acc[ai][bj][m][n], 0, 0, 0, 0, 0, 0)
#define PG8_MMA(ai, bj, At, Bt) do { __builtin_amdgcn_s_setprio(1); \
        if constexpr (FP8) { PG8_M8(ai, bj, 0, 0, Bt##_P); PG8_M8(ai, bj, 0, 1, Bt##_P); PG8_M8(ai, bj, 1, 0, Bt##_P); PG8_M8(ai, bj, 1, 1, Bt##_P); \
                             PG8_M8(ai, bj, 2, 0, Bt##_P); PG8_M8(ai, bj, 2, 1, Bt##_P); PG8_M8(ai, bj, 3, 0, Bt##_P); PG8_M8(ai, bj, 3, 1, Bt##_P); } \
        else { _Pragma("unroll") for (int m = 0; m < 4; ++m) _Pragma("unroll") for (int n = 0; n < 2; ++n) _Pragma("unroll") for (int k = 0; k < 2; ++k) \
            acc[ai][bj][m][n] = __builtin_amdgcn_mfma_f32_16x16x32_bf16(Bt[n][k], At[m][k], acc[ai][bj][m][n], 0, 0, 0); } \
        __builtin_amdgcn_s_setprio(0); } while (0)
#define PG8_WAIT_V(n) asm volatile("s_waitcnt vmcnt(" #n ")" ::: "memory")
#define PG8_WAIT_L(n) asm volatile("s_waitcnt lgkmcnt(" #n ")" ::: "memory")
#define PG8_BAR __builtin_amdgcn_s_barrier()
#define PG8_SCHED __builtin_amdgcn_sched_barrier(0)
    constexpr int B0_P = 0, B1_P = 16;
    Unit cur, nxt; int ui = 0;
    if (!S.next(0, cur)) return;
    f32x4 acc[2][2][4][2];
#pragma unroll
    for (int a = 0; a < 2; ++a)
#pragma unroll
        for (int b = 0; b < 2; ++b)
#pragma unroll
            for (int m = 0; m < 4; ++m)
#pragma unroll
                for (int n = 0; n < 2; ++n) acc[a][b][m][n] = (f32x4){0.f, 0.f, 0.f, 0.f};
    bf16x8 At[4][2], B0[2][2], B1[2][2]; i32x32 A32 = {}; i32x32 B32 = {};
    const char *cA0, *cA1, *cB0, *cB1;
    if constexpr (GATHER) {
        const int i00 = cur.gidx[R0], i01 = cur.gidx[R1], i10 = cur.gidx[HALF + R0], i11 = cur.gidx[HALF + R1];
        vA00 = (unsigned)(i00 * g.lda + C0 * 2); vA01 = (unsigned)(i01 * g.lda + C1 * 2); vA10 = (unsigned)(i10 * g.lda + C0 * 2); vA11 = (unsigned)(i11 * g.lda + C1 * 2);
        cA0 = cur.a; cA1 = cur.a;
    } else {
        vA00 = (unsigned)(R0 * g.lda + C0 * 2); vA01 = (unsigned)(R1 * g.lda + C1 * 2); vA10 = vA00; vA11 = vA01;
        cA0 = cur.a; cA1 = cur.a + hstepA;
    }
    cB0 = cur.b0; cB1 = cur.b1;
    PG8_STAGE(PG8_SB(0, 0), cB0, vB0, vB1); PG8_STAGE(PG8_SB(0, 1), cB1, vB0, vB1); PG8_STAGE(PG8_SA(0, 0), cA0, vA00, vA01); PG8_STAGE(PG8_SA(0, 1), cA1, vA10, vA11);
    if (wr == 1) PG8_BAR;
    PG8_WAIT_V(2); PG8_BAR;
    PG8_STAGE(PG8_SB(1, 0), cB0 + kstep, vB0, vB1); PG8_STAGE(PG8_SA(1, 0), cA0 + kstep, vA00, vA01); PG8_STAGE(PG8_SB(1, 1), cB1 + kstep, vB0, vB1);
    PG8_WAIT_V(6); PG8_BAR;
    for (;;) {
        const bool has_next = S.next(ui + 1, nxt);
        const char *nA0, *nA1, *nB0, *nB1;
        if (has_next) { nA0 = nxt.a; nA1 = GATHER ? nxt.a : nxt.a + hstepA; nB0 = nxt.b0; nB1 = nxt.b1; } else { nA0 = cA0; nA1 = cA1; nB0 = cB0; nB1 = cB1; }
        for (int t = 0; t < nt; t += 2) {
            const bool last = (t == nt - 2);
            const char* a1h1 = cA1 + (size_t)(t + 1) * kstep;
            const char* a2h0 = last ? nA0 : cA0 + (size_t)(t + 2) * kstep; const char* a2h1 = last ? nA1 : cA1 + (size_t)(t + 2) * kstep;
            const char* b2h0 = last ? nB0 : cB0 + (size_t)(t + 2) * kstep; const char* b2h1 = last ? nB1 : cB1 + (size_t)(t + 2) * kstep;
            PG8_LDB(B0, 0, 0); PG8_LDB(B1, 0, 1); PG8_SCHED; PG8_LDA(At, 0, 0); PG8_STAGE(PG8_SA(1, 1), a1h1, vA10, vA11);
            PG8_WAIT_V(8); PG8_WAIT_L(0); PG8_BAR; PG8_MMA(0, 0, At, B0); PG8_MMA(0, 1, At, B1); PG8_BAR; PG8_SCHED;
            if constexpr (GATHER) {
                if (last && has_next) { const int i00 = nxt.gidx[R0], i01 = nxt.gidx[R1], i10 = nxt.gidx[HALF + R0], i11 = nxt.gidx[HALF + R1];
                    vA00 = (unsigned)(i00 * g.lda + C0 * 2); vA01 = (unsigned)(i01 * g.lda + C1 * 2); vA10 = (unsigned)(i10 * g.lda + C0 * 2); vA11 = (unsigned)(i11 * g.lda + C1 * 2); }
            }
            PG8_LDA(At, 0, 1); PG8_STAGE(PG8_SB(0, 0), b2h0, vB0, vB1); PG8_STAGE(PG8_SB(0, 1), b2h1, vB0, vB1); PG8_STAGE(PG8_SA(0, 0), a2h0, vA00, vA01);
            PG8_WAIT_V(8); PG8_WAIT_L(0); PG8_BAR; PG8_MMA(1, 0, At, B0); PG8_MMA(1, 1, At, B1); PG8_BAR; PG8_SCHED;
            PG8_LDB(B0, 1, 0); PG8_LDB(B1, 1, 1); PG8_SCHED; PG8_LDA(At, 1, 0); PG8_STAGE(PG8_SA(0, 1), a2h1, vA10, vA11);
            PG8_WAIT_V(8); PG8_WAIT_L(0); PG8_BAR; PG8_MMA(0, 0, At, B0); PG8_MMA(0, 1, At, B1); PG8_BAR; PG8_SCHED;
            PG8_LDA(At, 1, 1); PG8_STAGE(PG8_SB(1, 0), b2h0 + kstep, vB0, vB1); PG8_STAGE(PG8_SB(1, 1), b2h1 + kstep, vB0, vB1); PG8_STAGE(PG8_SA(1, 0), a2h0 + kstep, vA00, vA01);
            PG8_WAIT_V(8); PG8_WAIT_L(0); PG8_BAR; PG8_MMA(1, 0, At, B0); PG8_MMA(1, 1, At, B1); PG8_BAR; PG8_SCHED;
        }
        if (wr == 0) PG8_BAR;
        E(acc, cur, wr, wc, fr, fq);
        if (!has_next) break;
#pragma unroll
        for (int a = 0; a < 2; ++a)
#pragma unroll
            for (int b = 0; b < 2; ++b)
#pragma unroll
                for (int m = 0; m < 4; ++m)
#pragma unroll
                    for (int n = 0; n < 2; ++n) acc[a][b][m][n] = (f32x4){0.f, 0.f, 0.f, 0.f};
        cur = nxt; cA0 = nA0; cA1 = nA1; cB0 = nB0; cB1 = nB1; ++ui;
        if (wr == 1) PG8_BAR;
    }
    PG8_WAIT_V(0);
    PG8_BAR;
#undef PG8_SA
#undef PG8_SB
#undef PG8_STAGE
#undef PG8_LDA
#undef PG8_LDB
#undef PG8_MMA
#undef PG8_INS4
#undef PG8_M8
#undef PG8_SUB8
#undef PG8_WAIT_V
#undef PG8_WAIT_L
#undef PG8_BAR
#undef PG8_SCHED
}
}

struct Args {
    const float* in[28];
    float* out; unsigned char* ws;
    int ph_lo, ph_hi, li, pad;
};
enum { IN_X = 0, IN_C, IN_CTX, IN_CCTX, IN_ADAW, IN_ADAB, IN_N1G, IN_N2G, IN_WIN, IN_CONVW, IN_CONVB, IN_LWA, IN_LBA, IN_LWX, IN_LBX, IN_LAM, IN_RNG, IN_LNG, IN_WOUT,
       IN_RW, IN_RB, IN_WG, IN_BG, IN_WU, IN_BU, IN_WD, IN_BD, IN_FNG };

enum { K_INPROJ = 0, K_SCORES, K_STATE, K_GATES, K_R3, K_OUT, K_MOE1, K_MOE2 };
template <int KIND> struct Sched {
    int G, c; unsigned char* ws; unsigned char* dout;
    __device__ __forceinline__ bool next(int i, pg8::Unit& u) const {
        const long Ll = (long)i * G + c;
        u.gidx = nullptr; u.r0 = 0; u.c0 = 0; u.e = 0;
        if constexpr (KIND == K_INPROJ) {
            if (Ll >= 3776) return false; const int L = (int)Ll;
            const char* HX = (const char*)(ws + WS_HX); const char* WT = (const char*)(ws + WS_WINT);
            if (L < 2624) {
                int pm, pn;
                if (L < 2560) { int pq; pg8::static_map(L, 128, 20, pm, pq); pn = pq < 8 ? pq : pq + 4; }
                else { const int l2 = L - 2560; pm = 128 + (l2 >> 2); pn = 16 + (l2 & 3); }
                u.a = HX + (size_t)pm * 256 * DM * 2; u.b0 = WT + (size_t)pn * 256 * DM * 2; u.b1 = u.b0 + (size_t)128 * DM * 2;
                const int part = pn >> 2;
                const size_t base = part == 0 ? WS_Q : (part == 1 ? WS_KT : (part == 3 ? WS_GT : (part == 4 ? WS_URAW : WS_YB)));
                u.out = (char*)(ws + base) + ((size_t)pm * 256 * 1024 + (size_t)(pn & 3) * 256) * 2; u.ldc = 1024;
            } else {
                int fm, tn; pg8::static_map(L - 2624, 8, 144, fm, tn);
                u.a = WT + (size_t)(1024 + 256 * fm) * DM * 2; u.b0 = HX + (size_t)tn * 256 * DM * 2; u.b1 = u.b0 + (size_t)128 * DM * 2;
                if (fm < 4) { u.out = (char*)(ws + WS_KTR) + ((size_t)fm * 256 * NT + (size_t)tn * 256) * 2; u.ldc = NT; }
                else { const int h = fm - 4;
                    if (tn < 128) { const int b = tn >> 3, cc = tn & 7; u.out = (char*)(ws + WS_BCAT) + (size_t)(((b * 4 + h) * 8 + cc)) * 256 * 768 * 2; }
                    else { const int b = tn - 128; u.out = (char*)(ws + WS_VTC) + (size_t)(b * 4 + h) * 256 * 768 * 2; }
                    u.ldc = 768; }
            }
            return true;
        } else if constexpr (KIND == K_SCORES) {
            if (Ll >= 512) return false; const int L = (int)Ll; const int bh = L >> 3, cc = L & 7, b = bh >> 2, h = bh & 3;
            char* acat = (char*)dout + ((size_t)bh * 2048 + (size_t)cc * 256) * 768 * 2;
            u.a = acat + 256 * 2; u.b0 = (const char*)(ws + WS_KR) + ((size_t)(b * 2048 + cc * 256) * 1024 + (size_t)h * 256) * 2; u.b1 = u.b0 + (size_t)128 * 1024 * 2;
            u.out = acat; u.ldc = 768; u.e = h; return true;
        } else if constexpr (KIND == K_STATE) {
            if (Ll >= 1152) return false; const int L = (int)Ll; const int bh = L / 18, rem = L % 18, ci = rem >> 1, dir = rem & 1, b = bh >> 2, h = bh & 3;
            u.a = ci == 0 ? (const char*)(ws + WS_VTC) + (size_t)bh * 256 * 768 * 2 : (const char*)(ws + WS_BCAT) + (size_t)(bh * 8 + (ci - 1)) * 256 * 768 * 2;
            const size_t tok0 = ci == 0 ? (size_t)NL + (size_t)b * 256 : (size_t)b * 2048 + (size_t)(ci - 1) * 256;
            u.b0 = (const char*)(ws + (dir ? WS_KDB : WS_KDF)) + ((size_t)h * 256 * NT + tok0) * 2; u.b1 = u.b0 + (size_t)128 * NT * 2;
            u.out = (char*)(ws + WS_SLOC) + (size_t)((bh * 2 + dir) * 9 + ci) * 65536 * 2; u.ldc = 256; return true;
        } else if constexpr (KIND == K_GATES) {
            if (Ll >= 2304) return false; int pm, pn; pg8::static_map((int)Ll, 144, 16, pm, pn);
            u.a = (const char*)(ws + WS_U) + ((size_t)pm * 256 * 1024 + (size_t)(pn >> 1) * 128) * 2;
            u.b0 = (const char*)(ws + WS_LRUBT) + (size_t)pn * 256 * 128 * 2; u.b1 = u.b0 + (size_t)128 * 128 * 2;
            u.out = (char*)(ws + WS_G) + ((size_t)pm * 256 * 4096 + (size_t)pn * 256) * 2; u.ldc = 4096; return true;
        } else if constexpr (KIND == K_R3) {
            if (Ll >= 512) return false; const int L = (int)Ll; const int bh = L >> 3, cc = L & 7, b = bh >> 2, h = bh & 3;
            u.a = (const char*)dout + ((size_t)bh * 2048 + (size_t)cc * 256) * 768 * 2;
            u.b0 = (const char*)(ws + WS_BCAT) + (size_t)(bh * 8 + cc) * 256 * 768 * 2; u.b1 = u.b0 + (size_t)128 * 768 * 2;
            u.out = (char*)(ws + WS_O) + ((size_t)(b * 2048 + cc * 256) * 1024 + (size_t)h * 256) * 2; u.ldc = 1024; return true;
        } else if constexpr (KIND == K_OUT) {
            if (Ll >= 1024) return false; int pm, pn; pg8::static_map((int)Ll, 128, 8, pm, pn);
            u.a = (const char*)(ws + WS_MRG) + (size_t)pm * 256 * DM * 2; u.b0 = (const char*)(ws + WS_WOT) + (size_t)pn * 256 * DM * 2; u.b1 = u.b0 + (size_t)128 * DM * 2;
            u.out = nullptr; u.ldc = DM; u.r0 = pm * 256; u.c0 = pn * 256; return true;
        } else if constexpr (KIND == K_MOE1) {
            const int* tile_e = (const int*)(ws + WS_TILEE); const int ntl = tile_e[1024];
            if (Ll >= (long)ntl * 16) return false; int mt, pn; pg8::static_map((int)Ll, ntl, 16, mt, pn);
            const int e = tile_e[mt];
            u.a = (const char*)(ws + WS_H2); u.gidx = (const int*)(ws + WS_TOKSLOT) + mt * 256;
            u.b0 = (const char*)(ws + WS_WG) + ((size_t)e * 2048 + (size_t)pn * 128) * DM; u.b1 = (const char*)(ws + WS_WU) + ((size_t)e * 2048 + (size_t)pn * 128) * DM;
            u.out = (char*)(ws + WS_ACT) + ((size_t)mt * 256 * DM + (size_t)pn * 128); u.ldc = DM; u.r0 = mt * 256; u.c0 = pn * 128; u.e = e; return true;
        } else {
            const int* tile_e = (const int*)(ws + WS_TILEE); const int ntl = tile_e[1024];
            if (Ll >= (long)ntl * 8) return false; int mt, pn; pg8::static_map((int)Ll, ntl, 8, mt, pn);
            const int e = tile_e[mt];
            u.a = (const char*)(ws + WS_ACT) + (size_t)mt * 256 * DM;
            u.b0 = (const char*)(ws + WS_WD) + ((size_t)e * 2048 + (size_t)pn * 256) * DM; u.b1 = u.b0 + (size_t)128 * DM;
            u.out = (char*)(ws + WS_Y) + ((size_t)mt * 256 * DM + (size_t)pn * 256) * 2; u.ldc = DM; u.r0 = mt * 256; u.c0 = pn * 256; u.e = e; return true;
        }
    }
};

struct EpiPlain {
    static constexpr bool PERM = true;
    __device__ __forceinline__ void operator()(const f32x4 (&acc)[2][2][4][2], const pg8::Unit& u, int wr, int wc, int fr, int fq) const {
        int rz = wr * 64 + fr, cz = wc * 32 + 8 * fq; asm volatile("" : "+v"(rz), "+v"(cz));
        bf16_t* base = (bf16_t*)u.out + (size_t)rz * u.ldc + cz;
#pragma unroll
        for (int ai = 0; ai < 2; ++ai)
#pragma unroll
            for (int m = 0; m < 4; ++m) { bf16_t* rowp = base + (size_t)(ai * 128 + m * 16) * u.ldc;
#pragma unroll
                for (int bj = 0; bj < 2; ++bj) { const f32x4 v0 = acc[ai][bj][m][0], v1 = acc[ai][bj][m][1];
                    u32x4 w; w.x = cvt_pk_bf16(v0[0], v0[1]); w.y = cvt_pk_bf16(v0[2], v0[3]); w.z = cvt_pk_bf16(v1[0], v1[1]); w.w = cvt_pk_bf16(v1[2], v1[3]);
                    *(u32x4*)(rowp + bj * 128) = w; } }
    }
};
struct EpiScores {
    static constexpr bool PERM = true;
    __device__ __forceinline__ void operator()(const f32x4 (&acc)[2][2][4][2], const pg8::Unit& u, int wr, int wc, int fr, int fq) const {
        const float lg = l2gamma(u.e);
        int iz = wr * 64 + fr, cz = wc * 32 + 8 * fq; asm volatile("" : "+v"(iz), "+v"(cz));
        bf16_t* base = (bf16_t*)u.out + (size_t)iz * u.ldc + cz;
#pragma unroll
        for (int ai = 0; ai < 2; ++ai)
#pragma unroll
            for (int m = 0; m < 4; ++m) { const int i = ai * 128 + m * 16 + iz; bf16_t* rowp = base + (size_t)(ai * 128 + m * 16) * u.ldc;
#pragma unroll
                for (int bj = 0; bj < 2; ++bj) { float o[8];
#pragma unroll
                    for (int n = 0; n < 2; ++n)
#pragma unroll
                        for (int q = 0; q < 4; ++q) { const int j = bj * 128 + cz + 4 * n + q; const int d = i - j; const int ad = d < 0 ? -d : d;
                            o[n * 4 + q] = acc[ai][bj][m][n][q] * fexp2((float)(ad - i - 1) * lg); }
                    *(u32x4*)(rowp + bj * 128) = pack8(o); }
                __builtin_amdgcn_sched_barrier(0); }
    }
};
struct EpiOut {
    static constexpr bool PERM = false;
    const float* x; const float* mod; float* X1;
    __device__ __forceinline__ void operator()(const f32x4 (&acc)[2][2][4][2], const pg8::Unit& u, int wr, int wc, int fr, int fq) const {
        int rz = wr * 64 + fr, cz = wc * 32 + 4 * fq; asm volatile("" : "+v"(rz), "+v"(cz));
        const int row0 = u.r0 + rz, col0 = u.c0 + cz; const int b = u.r0 >> 11;
        f32x4 gv[2][2];
#pragma unroll
        for (int bj = 0; bj < 2; ++bj)
#pragma unroll
            for (int n = 0; n < 2; ++n) gv[bj][n] = *(const f32x4*)(mod + (size_t)b * MODW + 2 * DM + col0 + bj * 128 + n * 16);
#pragma unroll
        for (int ai = 0; ai < 2; ++ai)
#pragma unroll
            for (int m = 0; m < 4; ++m) { const size_t off = (size_t)(row0 + ai * 128 + m * 16) * DM + col0;
#pragma unroll
                for (int bj = 0; bj < 2; ++bj)
#pragma unroll
                    for (int n = 0; n < 2; ++n) { const f32x4 xv = *(const f32x4*)(x + off + bj * 128 + n * 16);
                        *(f32x4*)(X1 + off + bj * 128 + n * 16) = xv + gv[bj][n] * acc[ai][bj][m][n]; }
                asm volatile("" ::: "memory"); }
    }
};
struct EpiSwiGLU {
    static constexpr bool PERM = true;
    const float* bg; const float* bu;
    __device__ __forceinline__ void operator()(const f32x4 (&acc)[2][2][4][2], const pg8::Unit& u, int wr, int wc, int fr, int fq) const {
        int rz = wr * 64 + fr, cl = wc * 32 + 8 * fq; asm volatile("" : "+v"(rz), "+v"(cl));
        const float* pg_ = bg + (size_t)u.e * DM + u.c0 + cl; const float* pu_ = bu + (size_t)u.e * DM + u.c0 + cl;
        const f32x4 g0 = *(const f32x4*)pg_, g1 = *(const f32x4*)(pg_ + 4), u0 = *(const f32x4*)pu_, u1 = *(const f32x4*)(pu_ + 4);
        unsigned char* base = (unsigned char*)u.out + (size_t)rz * DM + cl;
#pragma unroll
        for (int ai = 0; ai < 2; ++ai)
#pragma unroll
            for (int m = 0; m < 4; ++m) { float o[8];
#pragma unroll
                for (int n = 0; n < 2; ++n)
#pragma unroll
                    for (int q = 0; q < 4; ++q) { float gl = acc[ai][0][m][n][q] * (1.0f / (H2_SCALE * W_SCALE)) + (n ? g1[q] : g0[q]); float up = acc[ai][1][m][n][q] * (1.0f / (H2_SCALE * W_SCALE)) + (n ? u1[q] : u0[q]);
                        gl = fminf(gl, 7.0f); up = fminf(fmaxf(up, -7.0f), 7.0f);
                        o[n * 4 + q] = ACT_SCALE * (up + 1.0f) * gl * frcp(1.0f + fexp2(gl * (-1.702f * 1.44269504089f))); }
                *(u32x2*)(base + (size_t)(ai * 128 + m * 16) * DM) = pack8_fp8(o); }
    }
};
struct EpiDown {
    static constexpr bool PERM = true;
    const float* bd; const float* gate;
    __device__ __forceinline__ void operator()(const f32x4 (&acc)[2][2][4][2], const pg8::Unit& u, int wr, int wc, int fr, int fq) const {
        int rz = wr * 64 + fr, cl = wc * 32 + 8 * fq; asm volatile("" : "+v"(rz), "+v"(cl));
        const float* pb = bd + (size_t)u.e * DM + u.c0 + cl; const float* gp = gate + u.r0 + rz;
        bf16_t* base = (bf16_t*)u.out + (size_t)rz * DM + cl;
#pragma unroll
        for (int bj = 0; bj < 2; ++bj) { const f32x4 b0 = *(const f32x4*)(pb + bj * 128), b1 = *(const f32x4*)(pb + bj * 128 + 4);
#pragma unroll
            for (int ai = 0; ai < 2; ++ai)
#pragma unroll
                for (int m = 0; m < 4; ++m) { const float gt = gp[ai * 128 + m * 16];
                    const f32x4 v0 = (acc[ai][bj][m][0] * (1.0f / (ACT_SCALE * W_SCALE)) + b0) * gt, v1 = (acc[ai][bj][m][1] * (1.0f / (ACT_SCALE * W_SCALE)) + b1) * gt;
                    u32x4 w; w.x = cvt_pk_bf16(v0[0], v0[1]); w.y = cvt_pk_bf16(v0[2], v0[3]); w.z = cvt_pk_bf16(v1[0], v1[1]); w.w = cvt_pk_bf16(v1[2], v1[3]);
                    *(u32x4*)(base + (size_t)(ai * 128 + m * 16) * DM + bj * 128) = w; }
            __builtin_amdgcn_sched_barrier(0); }
    }
};

struct Frame {
    LAS unsigned char* lds; unsigned char* ws; float* out; const float* const* in;
    int tid, lane, wave, G, bid;
};
#define INP(k) (F.in[k])

__device__ __forceinline__ void p0_transpose_item(const float* W, int K, int N, bf16_t* WT, int row_off, LAS float* scr, int item, int lane) {
    const int nblk = N / 32, kb = item / nblk, nb = item % nblk, k0 = 64 * kb, n0 = 32 * nb;
#pragma unroll 8
    for (int i = 0; i < 32; ++i) { const int kk = 2 * i + (lane >> 5); scr[kk * 33 + (lane & 31)] = W[(size_t)(k0 + kk) * N + n0 + (lane & 31)]; }
    LDS_WAIT(); asm volatile("" ::: "memory");
    const int c = lane & 7;
#pragma unroll
    for (int j = 0; j < 4; ++j) { const int n = (lane >> 3) + 8 * j; const LAS float* s = scr + (8 * c) * 33 + n;
        u32x4 o; o.x = cvt_pk_bf16(s[0 * 33], s[1 * 33]); o.y = cvt_pk_bf16(s[2 * 33], s[3 * 33]); o.z = cvt_pk_bf16(s[4 * 33], s[5 * 33]); o.w = cvt_pk_bf16(s[6 * 33], s[7 * 33]);
        *(u32x4*)(WT + (size_t)(row_off + n0 + n) * K + k0 + 8 * c) = o; }
    LDS_WAIT(); asm volatile("" ::: "memory");
}
__device__ __forceinline__ void p0_transpose_item_fp8(const float* W, int K, int N, unsigned char* WT, LAS float* scr, int item, int lane) {
    const int nblk = N / 32, kb = item / nblk, nb = item % nblk, k0 = 64 * kb, n0 = 32 * nb;
#pragma unroll 8
    for (int i = 0; i < 32; ++i) { const int kk = 2 * i + (lane >> 5); scr[kk * 33 + (lane & 31)] = W[(size_t)(k0 + kk) * N + n0 + (lane & 31)]; }
    LDS_WAIT(); asm volatile("" ::: "memory");
    const int c = lane & 7;
#pragma unroll
    for (int j = 0; j < 4; ++j) { const int n = (lane >> 3) + 8 * j; const LAS float* s = scr + (8 * c) * 33 + n;
        u32x2 o; o.x = pk4_fp8(s[0 * 33] * W_SCALE, s[1 * 33] * W_SCALE, s[2 * 33] * W_SCALE, s[3 * 33] * W_SCALE); o.y = pk4_fp8(s[4 * 33] * W_SCALE, s[5 * 33] * W_SCALE, s[6 * 33] * W_SCALE, s[7 * 33] * W_SCALE);
        *(u32x2*)(WT + (size_t)(n0 + n) * K + k0 + 8 * c) = o; }
    LDS_WAIT(); asm volatile("" ::: "memory");
}
__device__ __forceinline__ void p0_ada_item(Frame& F, int item, LAS float* scr) {
    const int ks = item & 7, cg = item >> 3, n = cg * 64 + F.lane;
    const float* c = INP(IN_C); const float* cc = INP(IN_CCTX); const float* W = INP(IN_ADAW);
    float acc[17];
#pragma unroll
    for (int b = 0; b < 17; ++b) acc[b] = 0.f;
    for (int sub = 0; sub < 4; ++sub) {
        const int k0 = ks * 256 + sub * 64;
#pragma unroll
        for (int b = 0; b < 17; ++b) { const float v = b < 16 ? c[b * DM + k0 + F.lane] : cc[k0 + F.lane]; scr[F.lane * 20 + b] = v * fsigmoid(v); }
        LDS_WAIT(); asm volatile("" ::: "memory");
#pragma unroll 8
        for (int kk = 0; kk < 64; ++kk) { const float w = W[(size_t)(k0 + kk) * MODW + n];
            const LAS f32x4* sp = (const LAS f32x4*)(scr + kk * 20); const f32x4 s0 = sp[0], s1 = sp[1], s2 = sp[2], s3 = sp[3]; const float s16 = scr[kk * 20 + 16];
#pragma unroll
            for (int q = 0; q < 4; ++q) { acc[q] += s0[q] * w; acc[4 + q] += s1[q] * w; acc[8 + q] += s2[q] * w; acc[12 + q] += s3[q] * w; }
            acc[16] += s16 * w; }
        LDS_WAIT(); asm volatile("" ::: "memory");
    }
    float* mp = (float*)(F.ws + WS_MODP) + (size_t)ks * 17 * MODW + n;
#pragma unroll
    for (int b = 0; b < 17; ++b) mp[(size_t)b * MODW] = acc[b];
}
__device__ __forceinline__ void p0_prologue(Frame& F) {
    LAS float* scr = (LAS float*)(F.lds + F.wave * 16384);
    const int gw = F.bid * 8 + F.wave, NGW = F.G * 8;
    constexpr int I_ADA = 1536, I_IN = 32 * 192, I_OUT = 32 * 64, I_EXP = 96 * 2048, I_LRU = 32 * 8;
    constexpr int NITEMS = I_ADA + I_IN + I_OUT + I_EXP + I_LRU;
    for (int it = gw; it < NITEMS; it += NGW) {
        int r = it;
        if (r < I_ADA) { p0_ada_item(F, r, scr); continue; } r -= I_ADA;
        if (r < I_IN) { p0_transpose_item(INP(IN_WIN), DM, DIN, (bf16_t*)(F.ws + WS_WINT), 0, scr, r, F.lane); continue; } r -= I_IN;
        if (r < I_OUT) { p0_transpose_item(INP(IN_WOUT), DM, DM, (bf16_t*)(F.ws + WS_WOT), 0, scr, r, F.lane); continue; } r -= I_OUT;
        if (r < I_EXP) { const int m = r >> 11, item = r & 2047, which = m >> 5, e = m & 31;
            const float* W = (which == 0 ? INP(IN_WG) : (which == 1 ? INP(IN_WU) : INP(IN_WD))) + (size_t)e * DM * DM;
            unsigned char* WT = (unsigned char*)(F.ws + (which == 0 ? WS_WG : (which == 1 ? WS_WU : WS_WD))) + (size_t)e * DM * DM;
            p0_transpose_item_fp8(W, DM, DM, WT, scr, item, F.lane); continue; } r -= I_EXP;
        { const int mat = r >> 3, item = r & 7, which = mat >> 4, d = (mat >> 3) & 1, h = mat & 7;
          const float* W = (which == 0 ? INP(IN_LWA) : INP(IN_LWX)) + (size_t)(d * 8 + h) * 128 * 128;
          p0_transpose_item(W, 128, 128, (bf16_t*)(F.ws + WS_LRUBT), h * 512 + d * 256 + which * 128, scr, item, F.lane); }
    }
    const int gt = F.bid * 512 + F.tid, NGT = F.G * 512;
    for (int i = gt; i < 64 * 64; i += NGT) { const int pos = i >> 6, fi = i & 63;
        const float inv = fexp2(-(float)fi * (13.2877123795f / 64.0f)); const float rev = (float)pos * inv * 0.15915494309f; const float fr_ = rev - floorf(rev);
        ((f32x2*)(F.ws + WS_CS))[i] = (f32x2){__builtin_amdgcn_cosf(fr_), __builtin_amdgcn_sinf(fr_)}; }
    for (int i = gt; i < NE * DM; i += NGT) { const int e = i >> 11, k = i & 2047; ((float*)(F.ws + WS_RWT))[i] = INP(IN_RW)[(size_t)k * NE + e]; }
    for (int i = gt; i < 2 * DL; i += NGT) { const float lam = INP(IN_LAM)[i]; const float z = fexp(-lam);
        const float sp = z < 0.03f ? z * (1.0f - z * (0.5f - z * (0.33333333f - 0.25f * z))) : __builtin_amdgcn_logf(1.0f + z) * 0.69314718056f;
        ((float*)(F.ws + WS_C8SP))[i] = -8.0f * sp; }
}
__device__ __forceinline__ void p0b_mod(Frame& F) {
    const float* mp = (const float*)(F.ws + WS_MODP); float* mod = (float*)(F.ws + WS_MOD);
    for (int i = F.bid * 512 + F.tid; i < 17 * MODW; i += F.G * 512) { float s = INP(IN_ADAB)[i % MODW];
#pragma unroll
        for (int ks = 0; ks < 8; ++ks) s += mp[(size_t)ks * 17 * MODW + i];
        mod[i] = s; }
}
__device__ __forceinline__ void p1_norm1(Frame& F) {
    const float* mod = (const float*)(F.ws + WS_MOD); const float* n1g = INP(IN_N1G);
    bf16_t* HX = (bf16_t*)(F.ws + WS_HX);
    for (int row = F.bid * 8 + F.wave; row < NT; row += F.G * 8) {
        const int b = row < NL ? (row >> 11) : 16;
        const float* xr = row < NL ? INP(IN_X) + (size_t)row * DM : INP(IN_CTX) + (size_t)(row - NL) * DM;
        const f32x4* xp = (const f32x4*)xr + F.lane; f32x4 v[8]; float s = 0.f;
#pragma unroll
        for (int j = 0; j < 8; ++j) { v[j] = xp[64 * j]; s += (v[j].x * v[j].x + v[j].y * v[j].y) + (v[j].z * v[j].z + v[j].w * v[j].w); }
        const float rstd = 1.0f / sqrtf(wave_sum(s) * (1.0f / DM) + EPS);
        const f32x4* gp = (const f32x4*)n1g + F.lane; const f32x4* shp = (const f32x4*)(mod + (size_t)b * MODW) + F.lane; const f32x4* scp = (const f32x4*)(mod + (size_t)b * MODW + DM) + F.lane;
        u32x2* op = (u32x2*)(HX + (size_t)row * DM) + F.lane;
#pragma unroll
        for (int j = 0; j < 8; ++j) { const f32x4 g = gp[64 * j], sh = shp[64 * j], sc = scp[64 * j];
            const f32x4 y = v[j] * rstd * g * (1.0f + sc) + sh; u32x2 w; w.x = cvt_pk_bf16(y.x, y.y); w.y = cvt_pk_bf16(y.z, y.w); op[64 * j] = w; }
    }
}

__device__ __forceinline__ void p3_prep(Frame& F) {
    const int gt = F.bid * 512 + F.tid, NGT = F.G * 512;
    const f32x2* cs = (const f32x2*)(F.ws + WS_CS);
    {
        const bf16_t* Q = (const bf16_t*)(F.ws + WS_Q); const bf16_t* KT = (const bf16_t*)(F.ws + WS_KT);
        bf16_t* KR = (bf16_t*)(F.ws + WS_KR); bf16_t* AC = (bf16_t*)F.out;
        for (int it = gt; it < NL * 128; it += NGT) {
            const int row = it >> 7, sub = it & 127, which = sub >> 6, h = (sub >> 4) & 3, half = (sub >> 3) & 1, c8 = sub & 7;
            const int p = row & 2047, comp = half == 0 ? (p >> 6) : (p & 63);
            const int d1 = half * 128 + c8 * 8;
            const bf16_t* src = (which == 0 ? Q : KT) + (size_t)row * 1024 + h * 256 + d1;
            float x1[8], x2[8], o1[8], o2[8]; unpack8(*(const u32x4*)src, x1); unpack8(*(const u32x4*)(src + 64), x2);
            const f32x4* cp = (const f32x4*)(cs + comp * 64 + c8 * 8);
#pragma unroll
            for (int q = 0; q < 4; ++q) { const f32x4 t = cp[q];
                o1[2 * q] = x1[2 * q] * t.x - x2[2 * q] * t.y; o2[2 * q] = x1[2 * q] * t.y + x2[2 * q] * t.x;
                o1[2 * q + 1] = x1[2 * q + 1] * t.z - x2[2 * q + 1] * t.w; o2[2 * q + 1] = x1[2 * q + 1] * t.w + x2[2 * q + 1] * t.z; }
            if (which == 0) {
                const int i = row & 255, b = row >> 11, t_ = row & 2047; const float lg = l2gamma(h);
                const float ff = fexp2((float)(i + 1) * lg), fb = fexp2((float)(256 - i) * lg);
                bf16_t* dst = AC + ((size_t)(b * 4 + h) * 2048 + t_) * 768 + 256 + d1;
                float a[8], c[8];
#pragma unroll
                for (int q = 0; q < 8; ++q) { a[q] = o1[q] * ff; c[q] = o1[q] * fb; }
                *(u32x4*)dst = pack8(a); *(u32x4*)(dst + 256) = pack8(c);
#pragma unroll
                for (int q = 0; q < 8; ++q) { a[q] = o2[q] * ff; c[q] = o2[q] * fb; }
                *(u32x4*)(dst + 64) = pack8(a); *(u32x4*)(dst + 256 + 64) = pack8(c);
            } else {
                bf16_t* dst = KR + (size_t)row * 1024 + h * 256 + d1;
#pragma unroll
                for (int q = 0; q < 8; ++q) { o1[q] *= 0.0625f; o2[q] *= 0.0625f; }
                *(u32x4*)dst = pack8(o1); *(u32x4*)(dst + 64) = pack8(o2);
            }
        }
    }
    {
        const bf16_t* KTR = (const bf16_t*)(F.ws + WS_KTR); bf16_t* KDF = (bf16_t*)(F.ws + WS_KDF); bf16_t* KDB = (bf16_t*)(F.ws + WS_KDB);
        constexpr int NTG = NT / 8;
        for (int it = gt; it < 512 * NTG; it += NGT) {
            const int fp = it / NTG, tg = it - fp * NTG, h = fp >> 7, half = (fp >> 6) & 1, cc = fp & 63;
            const int f1 = h * 256 + half * 128 + cc, tok0 = tg * 8;
            float x1[8], x2[8], o1[8], o2[8];
            unpack8(*(const u32x4*)(KTR + (size_t)f1 * NT + tok0), x1); unpack8(*(const u32x4*)(KTR + (size_t)(f1 + 64) * NT + tok0), x2);
            if (tok0 < NL) {
                const int p0 = tok0 & 2047;
#pragma unroll
                for (int q = 0; q < 8; ++q) { const int comp = half == 0 ? (p0 >> 6) : ((p0 & 63) + q); const f32x2 t = cs[comp * 64 + cc];
                    o1[q] = x1[q] * t.x - x2[q] * t.y; o2[q] = x1[q] * t.y + x2[q] * t.x; }
            } else {
#pragma unroll
                for (int q = 0; q < 8; ++q) { o1[q] = x1[q]; o2[q] = x2[q]; }
            }
            const float lg = l2gamma(h); const int j0 = tok0 & 255;
            float a1[8], a2[8], c1[8], c2[8];
#pragma unroll
            for (int q = 0; q < 8; ++q) { const float df = 0.0625f * fexp2((float)(255 - j0 - q) * lg), db = 0.0625f * fexp2((float)(j0 + q) * lg);
                a1[q] = o1[q] * df; a2[q] = o2[q] * df; c1[q] = o1[q] * db; c2[q] = o2[q] * db; }
            *(u32x4*)(KDF + (size_t)f1 * NT + tok0) = pack8(a1); *(u32x4*)(KDF + (size_t)(f1 + 64) * NT + tok0) = pack8(a2);
            *(u32x4*)(KDB + (size_t)f1 * NT + tok0) = pack8(c1); *(u32x4*)(KDB + (size_t)(f1 + 64) * NT + tok0) = pack8(c2);
        }
    }
    {
        const bf16_t* UR = (const bf16_t*)(F.ws + WS_URAW); bf16_t* U = (bf16_t*)(F.ws + WS_U);
        const float* cw = INP(IN_CONVW); const float* cb = INP(IN_CONVB);
        for (int it = gt; it < NT * 128; it += NGT) {
            const int row = it >> 7, ch = (it & 127) * 8;
            const int t = row < NL ? (row & 2047) : ((row - NL) & 255), Ls = row < NL ? SEQ : NCTX;
            float o[8]; { const f32x4 b0 = *(const f32x4*)(cb + ch), b1 = *(const f32x4*)(cb + ch + 4);
#pragma unroll
                for (int q = 0; q < 4; ++q) { o[q] = b0[q]; o[4 + q] = b1[q]; } }
#pragma unroll
            for (int tap = 0; tap < 4; ++tap) { const int tt = t + tap - 1;
                if (tt >= 0 && tt < Ls) { float x[8]; unpack8(*(const u32x4*)(UR + (size_t)(row + tap - 1) * 1024 + ch), x);
                    const f32x4 w0 = *(const f32x4*)(cw + tap * DL + ch), w1 = *(const f32x4*)(cw + tap * DL + ch + 4);
#pragma unroll
                    for (int q = 0; q < 4; ++q) { o[q] += x[q] * w0[q]; o[4 + q] += x[4 + q] * w1[q]; } } }
            *(u32x4*)(U + (size_t)row * 1024 + ch) = pack8(o);
        }
    }
}

struct LruCh { float ba0, ba1, bx0, bx1, k0, k1; };
__device__ __forceinline__ void lru_ab(const LruCh& P, unsigned rw, unsigned iw, unsigned uw, float& a0, float& b0, float& a1, float& b1) {
    const float r0 = fsigmoid(bf_lo(rw) + P.ba0), r1 = fsigmoid(bf_hi(rw) + P.ba1), i0 = fsigmoid(bf_lo(iw) + P.bx0), i1 = fsigmoid(bf_hi(iw) + P.bx1);
    a0 = fexp(P.k0 * r0); a1 = fexp(P.k1 * r1);
    b0 = sqrtf(fmaxf((1.0f - a0) * (1.0f + a0), 0.f)) * (i0 * bf_lo(uw)); b1 = sqrtf(fmaxf((1.0f - a1) * (1.0f + a1), 0.f)) * (i1 * bf_hi(uw));
}
__device__ __forceinline__ int lru_row(int b, int d, int s) {
    if (s < NCTX) return NL + b * NCTX + (d ? (NCTX - 1 - s) : s);
    const int pl = s - NCTX; return b * SEQ + (d ? (SEQ - 1 - pl) : pl);
}
__device__ __forceinline__ void p5_prefix_and_summaries(Frame& F) {
    {
        const bf16_t* SL = (const bf16_t*)(F.ws + WS_SLOC); bf16_t* BC = (bf16_t*)(F.ws + WS_BCAT);
        for (int it = F.bid * 512 + F.tid; it < 128 * 8192; it += F.G * 512) {
            const int bhd = it >> 13, el = (it & 8191) * 8, bh = bhd >> 1, dir = bhd & 1, h = bh & 3, e = el >> 8, d = el & 255;
            const float cd = fexp2(256.0f * l2gamma(h));
            const bf16_t* sl = SL + (size_t)bhd * 9 * 65536 + el;
            float s[8]; unpack8(*(const u32x4*)sl, s);
#pragma unroll
            for (int st = 0; st < 8; ++st) { const int c = dir ? 7 - st : st;
                *(u32x4*)(BC + ((size_t)(bh * 8 + c) * 256 + e) * 768 + 256 + dir * 256 + d) = pack8(s);
                if (st < 7) { float x[8]; unpack8(*(const u32x4*)(sl + (size_t)(c + 1) * 65536), x);
#pragma unroll
                    for (int q = 0; q < 8; ++q) s[q] = s[q] * cd + x[q]; } }
        }
    }
    {
        const bf16_t* G = (const bf16_t*)(F.ws + WS_G); const bf16_t* U = (const bf16_t*)(F.ws + WS_U); const float* k8 = (const float*)(F.ws + WS_C8SP);
        float* SA = (float*)(F.ws + WS_SUMA); float* SB = (float*)(F.ws + WS_SUMB);
        const int ch = 2 * F.tid, blk = ch >> 7, cj = ch & 127;
        for (int it = F.bid; it < NB * 2 * NLCH; it += F.G) {
            const int ck = it % NLCH, bd = it / NLCH, d = bd & 1, b = bd >> 1;
            LruCh P; P.ba0 = INP(IN_LBA)[d * DL + ch]; P.ba1 = INP(IN_LBA)[d * DL + ch + 1]; P.bx0 = INP(IN_LBX)[d * DL + ch]; P.bx1 = INP(IN_LBX)[d * DL + ch + 1];
            P.k0 = k8[d * DL + ch]; P.k1 = k8[d * DL + ch + 1];
            const int gcol = blk * 512 + d * 256 + cj;
            float A0 = 1.f, A1 = 1.f, B0 = 0.f, B1 = 0.f;
#pragma unroll 8
            for (int t = 0; t < LCH; ++t) { const int row = lru_row(b, d, ck * LCH + t);
                const unsigned rw = *(const unsigned*)(G + (size_t)row * 4096 + gcol), iw = *(const unsigned*)(G + (size_t)row * 4096 + gcol + 128), uw = *(const unsigned*)(U + (size_t)row * 1024 + ch);
                float a0, b0, a1, b1; lru_ab(P, rw, iw, uw, a0, b0, a1, b1);
                A0 *= a0; A1 *= a1; B0 = a0 * B0 + b0; B1 = a1 * B1 + b1; }
            const size_t o = ((size_t)bd * NLCH + ck) * DL + ch;
            *(f32x2*)(SA + o) = (f32x2){A0, A1}; *(f32x2*)(SB + o) = (f32x2){B0, B1};
        }
    }
}
__device__ __forceinline__ void p6_carries(Frame& F) {
    const float* SA = (const float*)(F.ws + WS_SUMA); const float* SB = (const float*)(F.ws + WS_SUMB); float* CI = (float*)(F.ws + WS_CIN);
    for (int it = F.bid * 512 + F.tid; it < NB * 2 * DL; it += F.G * 512) {
        const int bd = it >> 10, ch = it & 1023; float h = 0.f;
#pragma unroll 8
        for (int ck = 0; ck < NLCH; ++ck) { const size_t o = ((size_t)bd * NLCH + ck) * DL + ch; CI[o] = h; h = SA[o] * h + SB[o]; }
    }
}
__device__ __forceinline__ float gelu_tanh(float y) { const float t = 0.7978845608f * (y + 0.044715f * y * y * y); const float e = fexp(2.0f * t); return 0.5f * y * (2.0f - 2.0f * frcp(e + 1.0f)); }
__device__ __forceinline__ void p7_merge(Frame& F) {
    bf16_t* MRG = (bf16_t*)(F.ws + WS_MRG);
    {
        const bf16_t* O = (const bf16_t*)(F.ws + WS_O); const bf16_t* GT = (const bf16_t*)(F.ws + WS_GT); const float* rng = INP(IN_RNG);
        for (int it = F.bid * 8 + F.wave; it < NL * 4; it += F.G * 8) {
            const int row = it >> 2, h = it & 3; const size_t off = (size_t)row * 1024 + h * 256 + 4 * F.lane;
            const u32x2 ow = *(const u32x2*)(O + off), gw = *(const u32x2*)(GT + off);
            const float o0 = bf_lo(ow.x), o1 = bf_hi(ow.x), o2 = bf_lo(ow.y), o3 = bf_hi(ow.y);
            const float mu = wave_sum((o0 + o1) + (o2 + o3)) * (1.0f / 256.0f);
            const float d0 = o0 - mu, d1 = o1 - mu, d2 = o2 - mu, d3 = o3 - mu;
            const float rstd = 1.0f / sqrtf(wave_sum((d0 * d0 + d1 * d1) + (d2 * d2 + d3 * d3)) * (1.0f / 256.0f) + EPS);
            const f32x4 gn = *(const f32x4*)(rng + h * 256 + 4 * F.lane);
            const float g0 = bf_lo(gw.x), g1 = bf_hi(gw.x), g2 = bf_lo(gw.y), g3 = bf_hi(gw.y);
            u32x2 w; w.x = cvt_pk_bf16(d0 * rstd * gn.x * g0 * fsigmoid(g0), d1 * rstd * gn.y * g1 * fsigmoid(g1)); w.y = cvt_pk_bf16(d2 * rstd * gn.z * g2 * fsigmoid(g2), d3 * rstd * gn.w * g3 * fsigmoid(g3));
            *(u32x2*)(MRG + (size_t)row * DM + h * 256 + 4 * F.lane) = w;
        }
    }
    {
        const bf16_t* G = (const bf16_t*)(F.ws + WS_G); const bf16_t* U = (const bf16_t*)(F.ws + WS_U); const bf16_t* YB = (const bf16_t*)(F.ws + WS_YB);
        const float* k8 = (const float*)(F.ws + WS_C8SP); const float* CI = (const float*)(F.ws + WS_CIN); const float* lng = INP(IN_LNG);
        LAS float* red = (LAS float*)(F.lds + LDS_MISC);
        LAS f32x2* hfl = (LAS f32x2*)F.lds + F.tid;
        const int ch = 2 * F.tid, blk = ch >> 7, cj = ch & 127;
        for (int it = F.bid; it < NB * (SEQ / LCH); it += F.G) {
            const int b = it >> 6, lc = it & 63; const int row0 = b * SEQ + lc * LCH;
            {
                LruCh P; P.ba0 = INP(IN_LBA)[ch]; P.ba1 = INP(IN_LBA)[ch + 1]; P.bx0 = INP(IN_LBX)[ch]; P.bx1 = INP(IN_LBX)[ch + 1]; P.k0 = k8[ch]; P.k1 = k8[ch + 1];
                const f32x2 ci = *(const f32x2*)(CI + ((size_t)(b * 2 + 0) * NLCH + 8 + lc) * DL + ch); float h0 = ci.x, h1 = ci.y;
                const bf16_t* gp = G + (size_t)row0 * 4096 + blk * 512 + cj; const bf16_t* up = U + (size_t)row0 * 1024 + ch;
#pragma unroll 4
                for (int t = 0; t < LCH; ++t) {
                    const unsigned rw = *(const unsigned*)(gp + (size_t)t * 4096), iw = *(const unsigned*)(gp + (size_t)t * 4096 + 128), uw = *(const unsigned*)(up + (size_t)t * 1024);
                    float a0, b0, a1, b1; lru_ab(P, rw, iw, uw, a0, b0, a1, b1);
                    h0 = a0 * h0 + b0; h1 = a1 * h1 + b1; hfl[t * 512] = (f32x2){h0, h1}; }
            }
            {
                LruCh P; P.ba0 = INP(IN_LBA)[DL + ch]; P.ba1 = INP(IN_LBA)[DL + ch + 1]; P.bx0 = INP(IN_LBX)[DL + ch]; P.bx1 = INP(IN_LBX)[DL + ch + 1]; P.k0 = k8[DL + ch]; P.k1 = k8[DL + ch + 1];
                const f32x2 ci = *(const f32x2*)(CI + ((size_t)(b * 2 + 1) * NLCH + 8 + (63 - lc)) * DL + ch); float h0 = ci.x, h1 = ci.y;
                const bf16_t* gp = G + (size_t)row0 * 4096 + blk * 512 + 256 + cj; const bf16_t* up = U + (size_t)row0 * 1024 + ch; const bf16_t* yp = YB + (size_t)row0 * 1024 + ch;
#pragma unroll 4
                for (int t = LCH - 1; t >= 0; --t) {
                    const unsigned rw = *(const unsigned*)(gp + (size_t)t * 4096), iw = *(const unsigned*)(gp + (size_t)t * 4096 + 128), uw = *(const unsigned*)(up + (size_t)t * 1024);
                    float a0, b0, a1, b1; lru_ab(P, rw, iw, uw, a0, b0, a1, b1);
                    h0 = a0 * h0 + b0; h1 = a1 * h1 + b1;
                    const unsigned yw = *(const unsigned*)(yp + (size_t)t * 1024); const f32x2 hf = hfl[t * 512];
                    const float w0 = (hf.x + h0) * gelu_tanh(bf_lo(yw)), w1 = (hf.y + h1) * gelu_tanh(bf_hi(yw));
                    hfl[t * 512] = (f32x2){w0, w1};
                    const float sq = wave_sum(w0 * w0 + w1 * w1); if (F.lane == 0) red[F.wave * LCH + t] = sq; }
            }
            __syncthreads();
            const f32x2 gn = *(const f32x2*)(lng + ch);
#pragma unroll 4
            for (int t = 0; t < LCH; ++t) { float sq = 0.f;
#pragma unroll
                for (int w = 0; w < 8; ++w) sq += red[w * LCH + t];
                const float rstd = 1.0f / sqrtf(sq * (1.0f / DL) + EPS); const f32x2 v = hfl[t * 512];
                *(unsigned*)(MRG + (size_t)(row0 + t) * DM + DR + ch) = cvt_pk_bf16(v.x * rstd * gn.x, v.y * rstd * gn.y); }
            __syncthreads();
        }
    }
}
__device__ __forceinline__ void p9_router(Frame& F) {
    const float* X1 = F.out; const float* mod = (const float*)(F.ws + WS_MOD); const float* n2g = INP(IN_N2G); const float* rwT = (const float*)(F.ws + WS_RWT); const float* rb = INP(IN_RB);
    unsigned char* H2 = (unsigned char*)(F.ws + WS_H2); int* topi = (int*)(F.ws + WS_TOPI); float* topg = (float*)(F.ws + WS_TOPG); int* cnt16 = (int*)(F.ws + WS_CNT16);
    LAS float* lgs = (LAS float*)(F.lds + F.wave * 16384); LAS int* ids = (LAS int*)(F.lds + F.wave * 16384 + 4096);
    const int rl = F.lane & 15, kq = F.lane >> 4;
    for (int g = F.bid * 8 + F.wave; g < NL / 16; g += F.G * 8) {
        const int tok = g * 16 + rl, b = tok >> 11;
        const f32x4* xp = (const f32x4*)(X1 + (size_t)tok * DM) + 4 * kq;
        float s = 0.f;
#pragma unroll 4
        for (int Q = 0; Q < 32; ++Q) {
#pragma unroll
            for (int j = 0; j < 4; ++j) { const f32x4 x = xp[16 * Q + j]; s += (x.x * x.x + x.y * x.y) + (x.z * x.z + x.w * x.w); } }
        s += __shfl_xor(s, 16); s += __shfl_xor(s, 32);
        const float rstd = 1.0f / sqrtf(s * (1.0f / DM) + EPS);
        const f32x4* gp = (const f32x4*)n2g + 4 * kq; const f32x4* shp = (const f32x4*)(mod + (size_t)b * MODW + 3 * DM) + 4 * kq; const f32x4* scp = (const f32x4*)(mod + (size_t)b * MODW + 4 * DM) + 4 * kq;
        const f32x4* w0p = (const f32x4*)(rwT + (size_t)rl * DM) + 4 * kq; const f32x4* w1p = (const f32x4*)(rwT + (size_t)(16 + rl) * DM) + 4 * kq;
        u32x4* hp = (u32x4*)(H2 + (size_t)tok * DM) + kq;
        f32x4 acc0 = (f32x4){0.f, 0.f, 0.f, 0.f}, acc1 = (f32x4){0.f, 0.f, 0.f, 0.f};
#pragma unroll 2
        for (int Q = 0; Q < 32; ++Q) {
            u32x4 hw;
#pragma unroll
            for (int j = 0; j < 4; ++j) {
                const f32x4 x = xp[16 * Q + j], gg = gp[16 * Q + j], sh = shp[16 * Q + j], sc = scp[16 * Q + j], w0 = w0p[16 * Q + j], w1 = w1p[16 * Q + j];
                const f32x4 h = x * rstd * gg * (1.0f + sc) + sh;
                hw[j] = pk4_fp8(h.x * H2_SCALE, h.y * H2_SCALE, h.z * H2_SCALE, h.w * H2_SCALE);
                acc0 = __builtin_amdgcn_mfma_f32_16x16x4f32(h.x, w0.x, acc0, 0, 0, 0); acc1 = __builtin_amdgcn_mfma_f32_16x16x4f32(h.x, w1.x, acc1, 0, 0, 0);
                acc0 = __builtin_amdgcn_mfma_f32_16x16x4f32(h.y, w0.y, acc0, 0, 0, 0); acc1 = __builtin_amdgcn_mfma_f32_16x16x4f32(h.y, w1.y, acc1, 0, 0, 0);
                acc0 = __builtin_amdgcn_mfma_f32_16x16x4f32(h.z, w0.z, acc0, 0, 0, 0); acc1 = __builtin_amdgcn_mfma_f32_16x16x4f32(h.z, w1.z, acc1, 0, 0, 0);
                acc0 = __builtin_amdgcn_mfma_f32_16x16x4f32(h.w, w0.w, acc0, 0, 0, 0); acc1 = __builtin_amdgcn_mfma_f32_16x16x4f32(h.w, w1.w, acc1, 0, 0, 0);
            }
            hp[4 * Q] = hw;
        }
        const float rb0 = rb[rl], rb1 = rb[16 + rl];
#pragma unroll
        for (int j = 0; j < 4; ++j) { lgs[(4 * kq + j) * 33 + rl] = acc0[j] + rb0; lgs[(4 * kq + j) * 33 + 16 + rl] = acc1[j] + rb1; }
        LDS_WAIT(); asm volatile("" ::: "memory");
        if (F.lane < 16) {
            float v0 = -3.0e38f, v1 = -3.0e38f, v2 = -3.0e38f, v3 = -3.0e38f; int i0 = 0, i1 = 0, i2 = 0, i3 = 0;
#pragma unroll
            for (int e = 0; e < NE; ++e) { float x = lgs[F.lane * 33 + e]; int xi = e;
                if (x > v0) { const float tv = v0; const int ti = i0; v0 = x; i0 = xi; x = tv; xi = ti; }
                if (x > v1) { const float tv = v1; const int ti = i1; v1 = x; i1 = xi; x = tv; xi = ti; }
                if (x > v2) { const float tv = v2; const int ti = i2; v2 = x; i2 = xi; x = tv; xi = ti; }
                if (x > v3) { v3 = x; i3 = xi; } }
            const float e1 = fexp(v1 - v0), e2 = fexp(v2 - v0), e3 = fexp(v3 - v0); const float inv = 1.0f / (1.0f + e1 + e2 + e3);
            const int t2 = g * 16 + F.lane;
            *(int4*)(topi + (size_t)t2 * 4) = make_int4(i0, i1, i2, i3); *(f32x4*)(topg + (size_t)t2 * 4) = (f32x4){inv, e1 * inv, e2 * inv, e3 * inv};
            ids[F.lane * 4 + 0] = i0; ids[F.lane * 4 + 1] = i1; ids[F.lane * 4 + 2] = i2; ids[F.lane * 4 + 3] = i3;
        }
        LDS_WAIT(); asm volatile("" ::: "memory");
        if (F.lane < NE) { int c = 0;
#pragma unroll 16
            for (int q = 0; q < 64; ++q) c += (ids[q] == F.lane) ? 1 : 0;
            cnt16[(size_t)g * NE + F.lane] = c; }
        LDS_WAIT(); asm volatile("" ::: "memory");
    }
}
__device__ __forceinline__ void p10_routing(Frame& F) {
    const int* cnt16 = (const int*)(F.ws + WS_CNT16); const int* topi = (const int*)(F.ws + WS_TOPI); const float* topg = (const float*)(F.ws + WS_TOPG);
    int* tokslot = (int*)(F.ws + WS_TOKSLOT); float* gateslot = (float*)(F.ws + WS_GATESLOT); int* slotof = (int*)(F.ws + WS_SLOTOF); int* tile_e = (int*)(F.ws + WS_TILEE);
    LAS int* L = (LAS int*)(F.lds);
    for (int seg = F.bid; seg < 256; seg += F.G) {
        { const int e = F.tid & 31, part = F.tid >> 5; int tot = 0, pre = 0;
#pragma unroll 1
          for (int s = part * 16; s < part * 16 + 16; ++s) { int ss = 0;
#pragma unroll 2
              for (int gi = 0; gi < 8; ++gi) ss += cnt16[(size_t)(8 * s + gi) * NE + e];
              tot += ss; if (s < seg) pre += ss; }
          L[part * 32 + e] = tot; L[512 + part * 32 + e] = pre; }
        __syncthreads();
        if (F.tid < 32) { int tot = 0, pre = 0;
#pragma unroll
            for (int p = 0; p < 16; ++p) { tot += L[p * 32 + F.tid]; pre += L[512 + p * 32 + F.tid]; }
            L[1024 + F.tid] = tot; L[1056 + F.tid] = (tot + 255) & ~255; L[1088 + F.tid] = pre; }
        __syncthreads();
        if (F.tid < 32) { int base = 0; for (int e = 0; e < 32; ++e) base += (e < F.tid) ? L[1056 + e] : 0; L[1120 + F.tid] = base; }
        __syncthreads();
        {
            const int g = 8 * seg + F.wave; LAS int* offs = L + 2048 + F.wave * 128; LAS int* ids = offs + 32;
            if (F.lane < 32) { int o = L[1120 + F.lane] + L[1088 + F.lane]; for (int gj = 0; gj < F.wave; ++gj) o += cnt16[(size_t)(8 * seg + gj) * NE + F.lane]; offs[F.lane] = o; }
            int4 my = make_int4(0, 0, 0, 0); f32x4 mg = (f32x4){0.f, 0.f, 0.f, 0.f}; const int tok = g * 16 + (F.lane & 15);
            if (F.lane < 16) { my = *(const int4*)(topi + (size_t)tok * 4); mg = *(const f32x4*)(topg + (size_t)tok * 4);
                ids[F.lane * 4 + 0] = my.x; ids[F.lane * 4 + 1] = my.y; ids[F.lane * 4 + 2] = my.z; ids[F.lane * 4 + 3] = my.w; }
            LDS_WAIT(); asm volatile("" ::: "memory");
            if (F.lane < 16) { int r0 = 0, r1 = 0, r2 = 0, r3 = 0;
                for (int t2 = 0; t2 < 16; ++t2) { if (t2 < F.lane) {
#pragma unroll
                        for (int k = 0; k < 4; ++k) { const int x = ids[t2 * 4 + k]; r0 += (x == my.x); r1 += (x == my.y); r2 += (x == my.z); r3 += (x == my.w); } } }
                const int s0 = offs[my.x] + r0, s1 = offs[my.y] + r1, s2 = offs[my.z] + r2, s3 = offs[my.w] + r3;
                tokslot[s0] = tok; tokslot[s1] = tok; tokslot[s2] = tok; tokslot[s3] = tok;
                gateslot[s0] = mg.x; gateslot[s1] = mg.y; gateslot[s2] = mg.z; gateslot[s3] = mg.w;
                *(int4*)(slotof + (size_t)tok * 4) = make_int4(s0, s1, s2, s3); }
        }
        if (seg < 32) { const int beg = L[1120 + seg] + L[1024 + seg], end = L[1120 + seg] + L[1056 + seg];
            for (int s = beg + F.tid; s < end; s += 512) { tokslot[s] = 0; gateslot[s] = 0.f; } }
        if (seg == 0) { const int ntl = (L[1120 + 31] + L[1056 + 31]) >> 8;
            for (int mt = F.tid; mt < ntl; mt += 512) { int e = 0;
                for (int q = 0; q < 32; ++q) { const int lo = L[1120 + q] >> 8, hi = (L[1120 + q] + L[1056 + q]) >> 8; if (mt >= lo && mt < hi) e = q; }
                tile_e[mt] = e; }
            if (F.tid == 0) tile_e[1024] = ntl; }
        __syncthreads();
    }
}
__device__ __forceinline__ void p13_final(Frame& F) {
    const float* mod = (const float*)(F.ws + WS_MOD); const bf16_t* Y = (const bf16_t*)(F.ws + WS_Y); const int* slotof = (const int*)(F.ws + WS_SLOTOF); const float* fng = INP(IN_FNG);
    for (int row = F.bid * 8 + F.wave; row < NL; row += F.G * 8) {
        const int b = row >> 11; const int4 sl = *(const int4*)(slotof + (size_t)row * 4);
        f32x4* xp = (f32x4*)(F.out + (size_t)row * DM) + F.lane; const f32x4* g2p = (const f32x4*)(mod + (size_t)b * MODW + 5 * DM) + F.lane;
        const u32x2* y0 = (const u32x2*)(Y + (size_t)sl.x * DM) + F.lane; const u32x2* y1 = (const u32x2*)(Y + (size_t)sl.y * DM) + F.lane;
        const u32x2* y2 = (const u32x2*)(Y + (size_t)sl.z * DM) + F.lane; const u32x2* y3 = (const u32x2*)(Y + (size_t)sl.w * DM) + F.lane;
        f32x4 v[8]; float s = 0.f;
#pragma unroll
        for (int j = 0; j < 8; ++j) { const u32x2 a = y0[64 * j], bq = y1[64 * j], c = y2[64 * j], d = y3[64 * j]; const f32x4 g2 = g2p[64 * j];
            f32x4 m; m.x = (bf_lo(a.x) + bf_lo(bq.x)) + (bf_lo(c.x) + bf_lo(d.x)); m.y = (bf_hi(a.x) + bf_hi(bq.x)) + (bf_hi(c.x) + bf_hi(d.x));
            m.z = (bf_lo(a.y) + bf_lo(bq.y)) + (bf_lo(c.y) + bf_lo(d.y)); m.w = (bf_hi(a.y) + bf_hi(bq.y)) + (bf_hi(c.y) + bf_hi(d.y));
            v[j] = xp[64 * j] + g2 * m; s += (v[j].x * v[j].x + v[j].y * v[j].y) + (v[j].z * v[j].z + v[j].w * v[j].w); }
        const float rstd = 1.0f / sqrtf(wave_sum(s) * (1.0f / DM) + EPS);
        const f32x4* fp = (const f32x4*)fng + F.lane;
#pragma unroll
        for (int j = 0; j < 8; ++j) xp[64 * j] = v[j] * rstd * fp[64 * j];
    }
}

constexpr int N_PHASES = 15;
__global__ void __launch_bounds__(512, 2) mk_fwd(Args args) {
    extern __shared__ __attribute__((aligned(16))) unsigned char lds_raw[];
    Frame F;
    F.lds = (LAS unsigned char*)lds_raw; F.ws = args.ws; F.out = args.out; F.in = args.in;
    F.tid = threadIdx.x; F.lane = F.tid & 63; F.wave = __builtin_amdgcn_readfirstlane(F.tid >> 6); F.G = gridDim.x; F.bid = blockIdx.x;
    volatile LAS unsigned* MISC = (volatile LAS unsigned*)(F.lds + LDS_MISC + 4096);
    if (F.tid < 64) MISC[F.tid] = 0u;
    __syncthreads();
    const int lo = args.ph_lo, hi = args.ph_hi;
    XcdBarrier bar; bar.bar = (unsigned*)(args.ws + WS_CTL) + CW_BAR; bar.x = 0; bar.st = nullptr;
    if (hi - lo > 1) bar = xcd_barrier_post((unsigned*)(args.ws + WS_CTL) + CW_BAR, MISC);
#ifndef ONLY_PH
#define ONLY_PH -1
#endif
#define IN(k) (lo <= (k) && (k) < hi && (ONLY_PH < 0 || ONLY_PH == (k)))
#define SEAM(k) do { if (IN(k) && IN((k) + 1)) xcd_barrier(bar); } while (0)
    LAS unsigned char* ring = F.lds;

    if (IN(0)) { p0_prologue(F); } SEAM(0);
    if (IN(1)) { p0b_mod(F); } SEAM(1);
    if (IN(2)) { p1_norm1(F); } SEAM(2);
    if (IN(3)) { Sched<K_INPROJ> S{F.G, F.bid, F.ws, (unsigned char*)F.out}; EpiPlain E; pg8::gemm_phase<EpiPlain, Sched<K_INPROJ>, false>(ring, pg8::Cfg{DM * 2, DM * 2, 32}, S, E); } SEAM(3);
    if (IN(4)) { p3_prep(F); } SEAM(4);
    if (IN(5)) {
        { Sched<K_SCORES> S{F.G, F.bid, F.ws, (unsigned char*)F.out}; EpiScores E; pg8::gemm_phase<EpiScores, Sched<K_SCORES>, false>(ring, pg8::Cfg{768 * 2, 1024 * 2, 4}, S, E); }
        { Sched<K_STATE> S{F.G, F.bid, F.ws, (unsigned char*)F.out}; EpiPlain E; pg8::gemm_phase<EpiPlain, Sched<K_STATE>, false>(ring, pg8::Cfg{768 * 2, NT * 2, 4}, S, E); }
        { Sched<K_GATES> S{F.G, F.bid, F.ws, (unsigned char*)F.out}; EpiPlain E; pg8::gemm_phase<EpiPlain, Sched<K_GATES>, false>(ring, pg8::Cfg{1024 * 2, 128 * 2, 2}, S, E); }
    } SEAM(5);
    if (IN(6)) { p5_prefix_and_summaries(F); } SEAM(6);
    if (IN(7)) { p6_carries(F);
        { Sched<K_R3> S{F.G, F.bid, F.ws, (unsigned char*)F.out}; EpiPlain E; pg8::gemm_phase<EpiPlain, Sched<K_R3>, false>(ring, pg8::Cfg{768 * 2, 768 * 2, 12}, S, E); } } SEAM(7);
    if (IN(8)) { p7_merge(F); } SEAM(8);
    if (IN(9)) { Sched<K_OUT> S{F.G, F.bid, F.ws, (unsigned char*)F.out}; EpiOut E{INP(IN_X), (const float*)(F.ws + WS_MOD), F.out}; pg8::gemm_phase<EpiOut, Sched<K_OUT>, false>(ring, pg8::Cfg{DM * 2, DM * 2, 32}, S, E); } SEAM(9);
    if (IN(10)) { p9_router(F); } SEAM(10);
    if (IN(11)) { p10_routing(F); } SEAM(11);
    if (IN(12)) { Sched<K_MOE1> S{F.G, F.bid, F.ws, (unsigned char*)F.out}; EpiSwiGLU E{INP(IN_BG), INP(IN_BU)}; pg8::gemm_phase<EpiSwiGLU, Sched<K_MOE1>, true, true>(ring, pg8::Cfg{DM, DM, 16}, S, E); } SEAM(12);
    if (IN(13)) { Sched<K_MOE2> S{F.G, F.bid, F.ws, (unsigned char*)F.out}; EpiDown E{INP(IN_BD), (const float*)(F.ws + WS_GATESLOT)}; pg8::gemm_phase<EpiDown, Sched<K_MOE2>, false, true>(ring, pg8::Cfg{DM, DM, 16}, S, E); } SEAM(13);
    if (IN(14)) { p13_final(F); }
#undef IN
#undef SEAM
}

extern "C" void kernel_launch(void* const* d_in, const int* in_sizes, int n_in, void* d_out, int out_size, void* d_ws, size_t ws_size, hipStream_t stream) {
    static int grid = 0;
    if (grid == 0) {
        if (n_in != 28 || out_size != NL * DM || ws_size < WS_END) { fprintf(stderr, "kernel_launch: unexpected shapes (n_in %d, out %d, ws %zu); nothing launched\n", n_in, out_size, ws_size); grid = -1; return; }
        int dev = 0, cus = 0, per_cu = 0;
        if (hipGetDevice(&dev) != hipSuccess || hipDeviceGetAttribute(&cus, hipDeviceAttributeMultiprocessorCount, dev) != hipSuccess) { grid = -1; return; }
        if (hipFuncSetAttribute((const void*)mk_fwd, hipFuncAttributeMaxDynamicSharedMemorySize, LDS_BYTES) != hipSuccess) { fprintf(stderr, "kernel_launch: hipFuncSetAttribute failed\n"); grid = -1; return; }
        if (hipOccupancyMaxActiveBlocksPerMultiprocessor(&per_cu, (const void*)mk_fwd, 512, LDS_BYTES) != hipSuccess || per_cu < 1) fprintf(stderr, "kernel_launch: occupancy query reports %d blocks per CU\n", per_cu);
        (void)hipGetLastError();
        grid = cus;
    }
    if (grid < 0) return;
    if (hipMemsetAsync((char*)d_ws + WS_CTL, 0, 131072, stream) != hipSuccess) return;
    Args a{};
    for (int i = 0; i < 28; ++i) a.in[i] = (const float*)d_in[i];
    a.out = (float*)d_out; a.ws = (unsigned char*)d_ws; a.pad = 0;
#if MK_MULTI
    for (int p = 0; p < N_PHASES; ++p) { a.ph_lo = p; a.ph_hi = p + 1; a.li = p; hipLaunchKernelGGL(mk_fwd, dim3(grid), dim3(512), LDS_BYTES, stream, a); }
#else
    a.ph_lo = 0; a.ph_hi = N_PHASES; a.li = 0;
    hipLaunchKernelGGL(mk_fwd, dim3(grid), dim3(512), LDS_BYTES, stream, a);
#endif
}
```

```cpp
#include <hip/hip_runtime.h>
#include <cstdio>
#include <cstdint>

#ifndef MK_MULTI
#define MK_MULTI 0
#endif

#define LAS __attribute__((address_space(3)))
#define GAS __attribute__((address_space(1)))
typedef unsigned short bf16_t;
typedef short bf16x8 __attribute__((ext_vector_type(8)));
typedef float f32x4 __attribute__((ext_vector_type(4)));
typedef float f32x2 __attribute__((ext_vector_type(2)));
typedef unsigned u32x4 __attribute__((ext_vector_type(4)));
typedef unsigned u32x2 __attribute__((ext_vector_type(2)));

constexpr int DM = 2048, NB = 16, SEQ = 2048, NCTX = 256;
constexpr int NL = NB * SEQ;
constexpr int NCT = NB * NCTX;
constexpr int NT = NL + NCT;
constexpr int NH = 4, HD = 256, DR = 1024, DL = 1024, DIN = 6144, NE = 32, TOPK = 4;
constexpr int PMAX = 139264;
constexpr int MODW = 6 * DM;
constexpr int LCH = 32, NLCH = (NCTX + SEQ) / LCH;
constexpr float EPS = 1e-6f;

constexpr size_t MiB = 1ull << 20;
constexpr size_t WS_CTL = 0;
constexpr size_t WS_MODP = 1 * MiB;
constexpr size_t WS_MOD = 8 * MiB;
constexpr size_t WS_CS = 9 * MiB;
constexpr size_t WS_RWT = WS_CS + 64 * 1024;
constexpr size_t WS_C8SP = WS_RWT + 256 * 1024;
constexpr size_t WS_TOPI = 10 * MiB;
constexpr size_t WS_TOPG = WS_TOPI + 512 * 1024;
constexpr size_t WS_CNT16 = WS_TOPG + 512 * 1024;
constexpr size_t WS_TOKSLOT = 12 * MiB;
constexpr size_t WS_GATESLOT = WS_TOKSLOT + 1 * MiB;
constexpr size_t WS_SLOTOF = WS_GATESLOT + 1 * MiB;
constexpr size_t WS_TILEE = WS_SLOTOF + 1 * MiB;
constexpr size_t WS_WINT = 16 * MiB;
constexpr size_t WS_WOT = 40 * MiB;
constexpr size_t WS_LRUBT = 48 * MiB;
constexpr size_t WS_WD = 64 * MiB;
constexpr size_t WS_WG = 320 * MiB;
constexpr size_t WS_WU = 576 * MiB;
constexpr size_t DYN = 832 * MiB;
constexpr size_t WS_HX = DYN;
constexpr size_t WS_Q = DYN + 144 * MiB;
constexpr size_t WS_KT = WS_Q + 64 * MiB;
constexpr size_t WS_KTR = WS_KT + 64 * MiB;
constexpr size_t WS_URAW = WS_KTR + 72 * MiB;
constexpr size_t WS_GT = WS_URAW + 72 * MiB;
constexpr size_t WS_YB = WS_GT + 64 * MiB;
constexpr size_t WS_BCAT = WS_YB + 64 * MiB;
constexpr size_t WS_VTC = WS_BCAT + 192 * MiB;
constexpr size_t WS_KR = WS_VTC + 24 * MiB;
constexpr size_t WS_KDF = WS_KR + 64 * MiB;
constexpr size_t WS_KDB = WS_KDF + 72 * MiB;
constexpr size_t WS_U = WS_KDB + 72 * MiB;
constexpr size_t WS_SLOC = WS_U + 72 * MiB;
constexpr size_t WS_SUMA = WS_SLOC + 144 * MiB;
constexpr size_t WS_SUMB = WS_SUMA + 9 * MiB;
constexpr size_t WS_CIN = WS_SUMB + 9 * MiB;
constexpr size_t WS_G = DYN;
constexpr size_t WS_O = DYN + 288 * MiB;
constexpr size_t WS_MRG = WS_KR;
constexpr size_t WS_H2 = DYN;
constexpr size_t WS_ACT = DYN + 128 * MiB;
constexpr size_t WS_Y = WS_ACT + 544 * MiB;
constexpr size_t WS_END = 2048 * MiB;
static_assert(WS_CIN + 9 * MiB <= WS_END && WS_Y + 544 * MiB <= WS_END && WS_G + 288 * MiB <= WS_KTR + 72 * MiB && WS_O + 64 * MiB <= WS_GT && WS_O >= WS_G + 288 * MiB && WS_MRG + 128 * MiB <= WS_KDB, "ws map");

constexpr int CW_BAR = 4096;
constexpr int LDS_RING = 131072, LDS_MISC = LDS_RING, LDS_BYTES = 147456;

__device__ __forceinline__ unsigned cvt_pk_bf16(float lo, float hi) { unsigned r; asm volatile("v_cvt_pk_bf16_f32 %0, %1, %2" : "=v"(r) : "v"(lo), "v"(hi)); return r; }
__device__ __forceinline__ float bf_lo(unsigned w) { return __uint_as_float(w << 16); }
__device__ __forceinline__ float bf_hi(unsigned w) { return __uint_as_float(w & 0xffff0000u); }
__device__ __forceinline__ void unpack8(const u32x4 w, float (&v)[8]) { v[0] = bf_lo(w.x); v[1] = bf_hi(w.x); v[2] = bf_lo(w.y); v[3] = bf_hi(w.y); v[4] = bf_lo(w.z); v[5] = bf_hi(w.z); v[6] = bf_lo(w.w); v[7] = bf_hi(w.w); }
__device__ __forceinline__ u32x4 pack8(const float (&v)[8]) { u32x4 w; w.x = cvt_pk_bf16(v[0], v[1]); w.y = cvt_pk_bf16(v[2], v[3]); w.z = cvt_pk_bf16(v[4], v[5]); w.w = cvt_pk_bf16(v[6], v[7]); return w; }
constexpr float W_SCALE = 32.0f, H2_SCALE = 4.0f, ACT_SCALE = 4.0f;
__device__ __forceinline__ unsigned pk4_fp8(float a, float b, float c, float d) { int w = __builtin_amdgcn_cvt_pk_fp8_f32(a, b, 0, false); w = __builtin_amdgcn_cvt_pk_fp8_f32(c, d, w, true); return (unsigned)w; }
__device__ __forceinline__ u32x2 pack8_fp8(const float (&v)[8]) { u32x2 w; w.x = pk4_fp8(v[0], v[1], v[2], v[3]); w.y = pk4_fp8(v[4], v[5], v[6], v[7]); return w; }
__device__ __forceinline__ float fexp2(float x) { return __builtin_amdgcn_exp2f(x); }
__device__ __forceinline__ float fexp(float x) { return __builtin_amdgcn_exp2f(x * 1.44269504089f); }
__device__ __forceinline__ float frcp(float x) { return __builtin_amdgcn_rcpf(x); }
__device__ __forceinline__ float fsigmoid(float x) { return frcp(1.0f + fexp(-x)); }
__device__ __forceinline__ float wave_sum(float v) {
#pragma unroll
    for (int o = 1; o < 64; o <<= 1) v += __shfl_xor(v, o);
    return v;
}
#define LDS_WAIT() asm volatile("s_waitcnt lgkmcnt(0)" ::: "memory")
#define VM_WAIT() asm volatile("s_waitcnt vmcnt(0)" ::: "memory")
__device__ __forceinline__ float l2gamma(int h) { return h == 0 ? -0.0458036896f : (h == 1 ? -0.0227200765f : (h == 2 ? -0.0113153091f : -0.0056465633f)); }

#define XB_TMO      128
#define XB_XCNT(j)  (256  + 64 * (j))
#define XB_XSUB(j)  (1280 + 64 * (j))
#define XB_XGEN(j)  (2304 + 64 * (j))
#define XB_TOP      3328
#define XB_TOPGEN   3392
#define XCD_BAR_WORDS 3456
#define XB_SPIN_CAP (1u << 18)
__device__ __forceinline__ unsigned xb_ld(unsigned* p)              { return __hip_atomic_load(p, __ATOMIC_RELAXED, __HIP_MEMORY_SCOPE_AGENT); }
__device__ __forceinline__ unsigned xb_add(unsigned* p, unsigned v) { return __hip_atomic_fetch_add(p, v, __ATOMIC_RELAXED, __HIP_MEMORY_SCOPE_AGENT); }
__device__ __forceinline__ unsigned xb_xcc_id() { return (unsigned)__builtin_amdgcn_s_getreg((3 << 11) | 20) & 0xFu; }
#define XB_SPIN(cond, bar) do { unsigned _sp = 0; while (cond) { __builtin_amdgcn_s_sleep(1); \
    if ((++_sp & 255u) == 0u) { if (xb_ld(&(bar)[XB_TMO])) break; if (_sp > XB_SPIN_CAP) { atomicAdd(&(bar)[XB_TMO], 1u); break; } } } } while (0)
struct XcdBarrier { unsigned* bar; unsigned x; volatile LAS unsigned* st; };
__device__ __forceinline__ XcdBarrier xcd_barrier_post(unsigned* bar, volatile LAS unsigned* st) {
    XcdBarrier b; b.bar = bar; b.x = xb_xcc_id(); b.st = st;
    if (threadIdx.x == 0) (void)xb_add(&bar[XB_XCNT(b.x)], 1u);
    return b;
}
__device__ __forceinline__ void xcd_barrier_complete(unsigned* bar, unsigned x, unsigned& nloc, unsigned& nx) {
    const unsigned G = gridDim.x * gridDim.y * gridDim.z;
    unsigned sum, cnt, mine, sp = 0u;
    for (;;) {
        sum = 0u; cnt = 0u; mine = 0u;
#pragma unroll
        for (unsigned j = 0; j < 16; ++j) { const unsigned c = xb_ld(&bar[XB_XCNT(j)]); sum += c; cnt += (c > 0u) ? 1u : 0u; mine = (j == x) ? c : mine; }
        if (sum == G) break;
        __builtin_amdgcn_s_sleep(1);
        if ((++sp & 255u) == 0u) { if (xb_ld(&bar[XB_TMO])) break; if (sp > XB_SPIN_CAP) { atomicAdd(&bar[XB_TMO], 1u); break; } }
    }
    nloc = mine > 0u ? mine : 1u; nx = cnt > 0u ? cnt : 1u;
}
__device__ __forceinline__ void xcd_barrier(const XcdBarrier& b) {
    asm volatile("s_waitcnt vmcnt(0)" ::: "memory");
    __syncthreads();
    if (threadIdx.x == 0) {
        unsigned* bar = b.bar;
        __builtin_amdgcn_s_waitcnt(0);
        unsigned nloc = b.st[0], nx = b.st[1];
        if (nloc == 0u) { xcd_barrier_complete(bar, b.x, nloc, nx); b.st[0] = nloc; b.st[1] = nx; }
        const unsigned old = xb_add(&bar[XB_XSUB(b.x)], 1u);
        const unsigned gen = old / nloc;
        if (old + 1u == (gen + 1u) * nloc) {
            __builtin_amdgcn_fence(__ATOMIC_RELEASE, "agent");
            asm volatile("s_waitcnt vmcnt(0)" ::: "memory");
            const unsigned og = xb_add(&bar[XB_TOP], 1u);
            const unsigned tg = og / nx;
            if (og + 1u == (tg + 1u) * nx) xb_add(&bar[XB_TOPGEN], 1u);
            else XB_SPIN(xb_ld(&bar[XB_TOPGEN]) == tg, bar);
            __builtin_amdgcn_fence(__ATOMIC_ACQUIRE, "agent");
            xb_add(&bar[XB_XGEN(b.x)], 1u);
            asm volatile("s_waitcnt vmcnt(0)" ::: "memory");
        } else {
            XB_SPIN(xb_ld(&bar[XB_XGEN(b.x)]) == gen, bar);
            __builtin_amdgcn_fence(__ATOMIC_ACQUIRE, "agent");
            asm volatile("s_waitcnt vmcnt(0)" ::: "memory");
        }
    }
    __syncthreads();
}

namespace pg8 {
constexpr int BM = 256, BK = 64, HALF = 128, HTB = HALF * BK * 2, STAGE_BYTES = 8 * HTB, NXCD = 8, WGM = 8;
__host__ __device__ __forceinline__ int lds_byte(int r, int c) { const int st = (r >> 4) * 2 + (c >> 5), rr = r & 15, cc = c & 31, ob = rr * 64 + cc * 2; return st * 1024 + (ob ^ (((ob >> 9) & 1) << 5)); }
__host__ __device__ __forceinline__ void stage_rc(int b, int& R, int& C) { const int st = b / 1024, sb = b % 1024, swz = sb ^ (((sb >> 9) & 1) << 5); R = (st >> 1) * 16 + swz / 64; C = (st & 1) * 32 + (swz % 64) / 2; }
__host__ __device__ __forceinline__ int perm32(int rho) { const int n = rho >> 4, i = rho & 15; return 8 * (i >> 2) + 4 * n + (i & 3); }

struct Unit { const char* a; const char* b0; const char* b1; char* out; const int* gidx; int ldc, r0, c0, e; };
struct Cfg { int lda, ldb, nt; };
typedef int i32x8 __attribute__((ext_vector_type(8)));
typedef int i32x4 __attribute__((ext_vector_type(4)));
typedef int i32x32 __attribute__((ext_vector_type(32)));

__device__ __forceinline__ void static_map(int L, int nM, int nN, int& pm, int& pn) {
    const int nwg = nM * nN; int wgid = L;
    { const int q = nwg / NXCD, r = nwg % NXCD, xcd = wgid % NXCD, off = wgid / NXCD; wgid = (xcd < r ? xcd * (q + 1) : r * (q + 1) + (xcd - r) * q) + off; }
    const int nig = WGM * nN, gid = wgid / nig, fm = gid * WGM, gsz = (nM - fm) < WGM ? (nM - fm) : WGM;
    pm = fm + ((wgid % nig) % gsz); pn = (wgid % nig) / gsz;
}

template <class Epi, class Sched, bool GATHER, bool FP8 = false>
__device__ __forceinline__ void gemm_phase(LAS unsigned char* lds, const Cfg g, const Sched& S, const Epi& E) {
    const int tid = threadIdx.x, wid = __builtin_amdgcn_readfirstlane(tid >> 6), lane = tid & 63, wr = wid >> 2, wc = wid & 3, fr = lane & 15, fq = lane >> 4;
    int nt = g.nt; asm volatile("" : "+s"(nt));
    int R0, C0, R1, C1; stage_rc(tid * 16, R0, C0); stage_rc(tid * 16 + 8192, R1, C1);
    const int Rb0 = Epi::PERM ? ((R0 & ~31) + perm32(R0 & 31)) : R0, Rb1 = Epi::PERM ? ((R1 & ~31) + perm32(R1 & 31)) : R1;
    const unsigned vB0 = (unsigned)(Rb0 * g.ldb + C0 * 2), vB1 = (unsigned)(Rb1 * g.ldb + C1 * 2);
    unsigned vA00, vA01, vA10, vA11;
    const size_t kstep = (size_t)(BK * 2);
    const size_t hstepA = (size_t)HALF * g.lda;
    const unsigned ldsw = (unsigned)wid * 1024u;
    const int aoff = lds_byte(wr * 64 + fr, fq * 8), boff = lds_byte(wc * 32 + fr, fq * 8);
#define PG8_SA(b, h) (((b) * 2 + (h)) * HTB)
#define PG8_SB(b, h) ((4 + (b) * 2 + (h)) * HTB)
#define PG8_STAGE(bufoff, gbase, v0, v1) do { const GAS char* _gb = (const GAS char*)(gbase); unsigned _v0 = (v0), _v1 = (v1); asm volatile("" : "+s"(_gb), "+v"(_v0), "+v"(_v1));     \
        __builtin_amdgcn_global_load_lds((const GAS unsigned*)(_gb + _v0), (LAS unsigned*)(lds + (bufoff) + ldsw), 16, 0, 0); \
        __builtin_amdgcn_global_load_lds((const GAS unsigned*)(_gb + _v1), (LAS unsigned*)(lds + (bufoff) + ldsw + 8192), 16, 0, 0); } while (0)
#define PG8_INS4(big, pos, addr) do { const i32x4 _v = *(const LAS i32x4*)(addr); big[(pos) + 0] = _v.x; big[(pos) + 1] = _v.y; big[(pos) + 2] = _v.z; big[(pos) + 3] = _v.w; } while (0)
#define PG8_SUB8(big, pos) __builtin_shufflevector(big, big, (pos), (pos) + 1, (pos) + 2, (pos) + 3, (pos) + 4, (pos) + 5, (pos) + 6, (pos) + 7)
#define PG8_LDA(dst, b, h) do { if constexpr (FP8) { _Pragma("unroll") for (int m = 0; m < 4; ++m) { PG8_INS4(A32, 8 * m, lds + PG8_SA(b, h) + aoff + m * 2048); PG8_INS4(A32, 8 * m + 4, lds + PG8_SA(b, h) + aoff + m * 2048 + 1024); } } \
        else { _Pragma("unroll") for (int m = 0; m < 4; ++m) _Pragma("unroll") for (int k = 0; k < 2; ++k) dst[m][k] = *(const LAS bf16x8*)(lds + PG8_SA(b, h) + aoff + m * 2048 + k * 1024); } } while (0)
#define PG8_LDB(dst, b, h) do { if constexpr (FP8) { _Pragma("unroll") for (int n = 0; n < 2; ++n) { PG8_INS4(B32, dst##_P + 8 * n, lds + PG8_SB(b, h) + boff + n * 2048); PG8_INS4(B32, dst##_P + 8 * n + 4, lds + PG8_SB(b, h) + boff + n * 2048 + 1024); } } \
        else { _Pragma("unroll") for (int n = 0; n < 2; ++n) _Pragma("unroll") for (int k = 0; k < 2; ++k) dst[n][k] = *(const LAS bf16x8*)(lds + PG8_SB(b, h) + boff + n * 2048 + k * 1024); } } while (0)
#define PG8_M8(ai, bj, m, n, BP) acc[ai][bj][m][n] = __builtin_amdgcn_mfma_scale_f32_16x16x128_f8f6f4(PG8_SUB8(B32, (BP) + 8 * (n)), PG8_SUB8(A32, 8 * (m)), acc[ai][bj][m][n], 0, 0, 0, 0, 0, 0)
#define PG8_MMA(ai, bj, At, Bt) do { __builtin_amdgcn_s_setprio(1); \
        if constexpr (FP8) { PG8_M8(ai, bj, 0, 0, Bt##_P); PG8_M8(ai, bj, 0, 1, Bt##_P); PG8_M8(ai, bj, 1, 0, Bt##_P); PG8_M8(ai, bj, 1, 1, Bt##_P); \
                             PG8_M8(ai, bj, 2, 0, Bt##_P); PG8_M8(ai, bj, 2, 1, Bt##_P); PG8_M8(ai, bj, 3, 0, Bt##_P); PG8_M8(ai, bj, 3, 1, Bt##_P); } \
        else { _Pragma("unroll") for (int m = 0; m < 4; ++m) _Pragma("unroll") for (int n = 0; n < 2; ++n) _Pragma("unroll") for (int k = 0; k < 2; ++k) \
            acc[ai][bj][m][n] = __builtin_amdgcn_mfma_f32_16x16x32_bf16(Bt[n][k], At[m][k], acc[ai][bj][m][n], 0, 0, 0); } \
        __builtin_amdgcn_s_setprio(0); } while (0)
#define PG8_WAIT_V(n) asm volatile("s_waitcnt vmcnt(" #n ")" ::: "memory")
#define PG8_WAIT_L(n) asm volatile("s_waitcnt lgkmcnt(" #n ")" ::: "memory")
#define PG8_BAR __builtin_amdgcn_s_barrier()
#define PG8_SCHED __builtin_amdgcn_sched_barrier(0)
    constexpr int B0_P = 0, B1_P = 16;
    Unit cur, nxt; int ui = 0;
    if (!S.next(0, cur)) return;
    f32x4 acc[2][2][4][2];
#pragma unroll
    for (int a = 0; a < 2; ++a)
#pragma unroll
        for (int b = 0; b < 2; ++b)
#pragma unroll
            for (int m = 0; m < 4; ++m)
#pragma unroll
                for (int n = 0; n < 2; ++n) acc[a][b][m][n] = (f32x4){0.f, 0.f, 0.f, 0.f};
    bf16x8 At[4][2], B0[2][2], B1[2][2]; i32x32 A32 = {}; i32x32 B32 = {};
    const char *cA0, *cA1, *cB0, *cB1;
    if constexpr (GATHER) {
        const int i00 = cur.gidx[R0], i01 = cur.gidx[R1], i10 = cur.gidx[HALF + R0], i11 = cur.gidx[HALF + R1];
        vA00 = (unsigned)(i00 * g.lda + C0 * 2); vA01 = (unsigned)(i01 * g.lda + C1 * 2); vA10 = (unsigned)(i10 * g.lda + C0 * 2); vA11 = (unsigned)(i11 * g.lda + C1 * 2);
        cA0 = cur.a; cA1 = cur.a;
    } else {
        vA00 = (unsigned)(R0 * g.lda + C0 * 2); vA01 = (unsigned)(R1 * g.lda + C1 * 2); vA10 = vA00; vA11 = vA01;
        cA0 = cur.a; cA1 = cur.a + hstepA;
    }
    cB0 = cur.b0; cB1 = cur.b1;
    PG8_STAGE(PG8_SB(0, 0), cB0, vB0, vB1); PG8_STAGE(PG8_SB(0, 1), cB1, vB0, vB1); PG8_STAGE(PG8_SA(0, 0), cA0, vA00, vA01); PG8_STAGE(PG8_SA(0, 1), cA1, vA10, vA11);
    if (wr == 1) PG8_BAR;
    PG8_WAIT_V(2); PG8_BAR;
    PG8_STAGE(PG8_SB(1, 0), cB0 + kstep, vB0, vB1); PG8_STAGE(PG8_SA(1, 0), cA0 + kstep, vA00, vA01); PG8_STAGE(PG8_SB(1, 1), cB1 + kstep, vB0, vB1);
    PG8_WAIT_V(6); PG8_BAR;
    for (;;) {
        const bool has_next = S.next(ui + 1, nxt);
        const char *nA0, *nA1, *nB0, *nB1;
        if (has_next) { nA0 = nxt.a; nA1 = GATHER ? nxt.a : nxt.a + hstepA; nB0 = nxt.b0; nB1 = nxt.b1; } else { nA0 = cA0; nA1 = cA1; nB0 = cB0; nB1 = cB1; }
        for (int t = 0; t < nt; t += 2) {
            const bool last = (t == nt - 2);
            const char* a1h1 = cA1 + (size_t)(t + 1) * kstep;
            const char* a2h0 = last ? nA0 : cA0 + (size_t)(t + 2) * kstep; const char* a2h1 = last ? nA1 : cA1 + (size_t)(t + 2) * kstep;
            const char* b2h0 = last ? nB0 : cB0 + (size_t)(t + 2) * kstep; const char* b2h1 = last ? nB1 : cB1 + (size_t)(t + 2) * kstep;
            PG8_LDB(B0, 0, 0); PG8_LDB(B1, 0, 1); PG8_SCHED; PG8_LDA(At, 0, 0); PG8_STAGE(PG8_SA(1, 1), a1h1, vA10, vA11);
            PG8_WAIT_V(8); PG8_WAIT_L(0); PG8_BAR; PG8_MMA(0, 0, At, B0); PG8_MMA(0, 1, At, B1); PG8_BAR; PG8_SCHED;
            if constexpr (GATHER) {
                if (last && has_next) { const int i00 = nxt.gidx[R0], i01 = nxt.gidx[R1], i10 = nxt.gidx[HALF + R0], i11 = nxt.gidx[HALF + R1];
                    vA00 = (unsigned)(i00 * g.lda + C0 * 2); vA01 = (unsigned)(i01 * g.lda + C1 * 2); vA10 = (unsigned)(i10 * g.lda + C0 * 2); vA11 = (unsigned)(i11 * g.lda + C1 * 2); }
            }
            PG8_LDA(At, 0, 1); PG8_STAGE(PG8_SB(0, 0), b2h0, vB0, vB1); PG8_STAGE(PG8_SB(0, 1), b2h1, vB0, vB1); PG8_STAGE(PG8_SA(0, 0), a2h0, vA00, vA01);
            PG8_WAIT_V(8); PG8_WAIT_L(0); PG8_BAR; PG8_MMA(1, 0, At, B0); PG8_MMA(1, 1, At, B1); PG8_BAR; PG8_SCHED;
            PG8_LDB(B0, 1, 0); PG8_LDB(B1, 1, 1); PG8_SCHED; PG8_LDA(At, 1, 0); PG8_STAGE(PG8_SA(0, 1), a2h1, vA10, vA11);
            PG8_WAIT_V(8); PG8_WAIT_L(0); PG8_BAR; PG8_MMA(0, 0, At, B0); PG8_MMA(0, 1, At, B1); PG8_BAR; PG8_SCHED;
            PG8_LDA(At, 1, 1); PG8_STAGE(PG8_SB(1, 0), b2h0 + kstep, vB0, vB1); PG8_STAGE(PG8_SB(1, 1), b2h1 + kstep, vB0, vB1); PG8_STAGE(PG8_SA(1, 0), a2h0 + kstep, vA00, vA01);
            PG8_WAIT_V(8); PG8_WAIT_L(0); PG8_BAR; PG8_MMA(1, 0, At, B0); PG8_MMA(1, 1, At, B1); PG8_BAR; PG8_SCHED;
        }
        if (wr == 0) PG8_BAR;
        E(acc, cur, wr, wc, fr, fq);
        if (!has_next) break;
#pragma unroll
        for (int a = 0; a < 2; ++a)
#pragma unroll
            for (int b = 0; b < 2; ++b)
#pragma unroll
                for (int m = 0; m < 4; ++m)
#pragma unroll
                    for (int n = 0; n < 2; ++n) acc[a][b][m][n] = (f32x4){0.f, 0.f, 0.f, 0.f};
        cur = nxt; cA0 = nA0; cA1 = nA1; cB0 = nB0; cB1 = nB1; ++ui;
        if (wr == 1) PG8_BAR;
    }
    PG8_WAIT_V(0);
    PG8_BAR;
#undef PG8_SA
#undef PG8_SB
#undef PG8_STAGE
#undef PG8_LDA
#undef PG8_LDB
#undef PG8_MMA
#undef PG8_INS4
#undef PG8_M8
#undef PG8_SUB8
#undef PG8_WAIT_V
#undef PG8_WAIT_L
#undef PG8_BAR
#undef PG8_SCHED
}
}

struct Args {
    const float* in[28];
    float* out; unsigned char* ws;
    int ph_lo, ph_hi, li, pad;
};
enum { IN_X = 0, IN_C, IN_CTX, IN_CCTX, IN_ADAW, IN_ADAB, IN_N1G, IN_N2G, IN_WIN, IN_CONVW, IN_CONVB, IN_LWA, IN_LBA, IN_LWX, IN_LBX, IN_LAM, IN_RNG, IN_LNG, IN_WOUT,
       IN_RW, IN_RB, IN_WG, IN_BG, IN_WU, IN_BU, IN_WD, IN_BD, IN_FNG };

enum { K_INPROJ = 0, K_SCORES, K_STATE, K_GATES, K_R3, K_OUT, K_MOE1, K_MOE2 };
template <int KIND> struct Sched {
    int G, c; unsigned char* ws; unsigned char* dout;
    __device__ __forceinline__ bool next(int i, pg8::Unit& u) const {
        const long Ll = (long)i * G + c;
        u.gidx = nullptr; u.r0 = 0; u.c0 = 0; u.e = 0;
        if constexpr (KIND == K_INPROJ) {
            if (Ll >= 3776) return false; const int L = (int)Ll;
            const char* HX = (const char*)(ws + WS_HX); const char* WT = (const char*)(ws + WS_WINT);
            if (L < 2624) {
                int pm, pn;
                if (L < 2560) { int pq; pg8::static_map(L, 128, 20, pm, pq); pn = pq < 8 ? pq : pq + 4; }
                else { const int l2 = L - 2560; pm = 128 + (l2 >> 2); pn = 16 + (l2 & 3); }
                u.a = HX + (size_t)pm * 256 * DM * 2; u.b0 = WT + (size_t)pn * 256 * DM * 2; u.b1 = u.b0 + (size_t)128 * DM * 2;
                const int part = pn >> 2;
                const size_t base = part == 0 ? WS_Q : (part == 1 ? WS_KT : (part == 3 ? WS_GT : (part == 4 ? WS_URAW : WS_YB)));
                u.out = (char*)(ws + base) + ((size_t)pm * 256 * 1024 + (size_t)(pn & 3) * 256) * 2; u.ldc = 1024;
            } else {
                int fm, tn; pg8::static_map(L - 2624, 8, 144, fm, tn);
                u.a = WT + (size_t)(1024 + 256 * fm) * DM * 2; u.b0 = HX + (size_t)tn * 256 * DM * 2; u.b1 = u.b0 + (size_t)128 * DM * 2;
                if (fm < 4) { u.out = (char*)(ws + WS_KTR) + ((size_t)fm * 256 * NT + (size_t)tn * 256) * 2; u.ldc = NT; }
                else { const int h = fm - 4;
                    if (tn < 128) { const int b = tn >> 3, cc = tn & 7; u.out = (char*)(ws + WS_BCAT) + (size_t)(((b * 4 + h) * 8 + cc)) * 256 * 768 * 2; }
                    else { const int b = tn - 128; u.out = (char*)(ws + WS_VTC) + (size_t)(b * 4 + h) * 256 * 768 * 2; }
                    u.ldc = 768; }
            }
            return true;
        } else if constexpr (KIND == K_SCORES) {
            if (Ll >= 512) return false; const int L = (int)Ll; const int bh = L >> 3, cc = L & 7, b = bh >> 2, h = bh & 3;
            char* acat = (char*)dout + ((size_t)bh * 2048 + (size_t)cc * 256) * 768 * 2;
            u.a = acat + 256 * 2; u.b0 = (const char*)(ws + WS_KR) + ((size_t)(b * 2048 + cc * 256) * 1024 + (size_t)h * 256) * 2; u.b1 = u.b0 + (size_t)128 * 1024 * 2;
            u.out = acat; u.ldc = 768; u.e = h; return true;
        } else if constexpr (KIND == K_STATE) {
            if (Ll >= 1152) return false; const int L = (int)Ll; const int bh = L / 18, rem = L % 18, ci = rem >> 1, dir = rem & 1, b = bh >> 2, h = bh & 3;
            u.a = ci == 0 ? (const char*)(ws + WS_VTC) + (size_t)bh * 256 * 768 * 2 : (const char*)(ws + WS_BCAT) + (size_t)(bh * 8 + (ci - 1)) * 256 * 768 * 2;
            const size_t tok0 = ci == 0 ? (size_t)NL + (size_t)b * 256 : (size_t)b * 2048 + (size_t)(ci - 1) * 256;
            u.b0 = (const char*)(ws + (dir ? WS_KDB : WS_KDF)) + ((size_t)h * 256 * NT + tok0) * 2; u.b1 = u.b0 + (size_t)128 * NT * 2;
            u.out = (char*)(ws + WS_SLOC) + (size_t)((bh * 2 + dir) * 9 + ci) * 65536 * 2; u.ldc = 256; return true;
        } else if constexpr (KIND == K_GATES) {
            if (Ll >= 2304) return false; int pm, pn; pg8::static_map((int)Ll, 144, 16, pm, pn);
            u.a = (const char*)(ws + WS_U) + ((size_t)pm * 256 * 1024 + (size_t)(pn >> 1) * 128) * 2;
            u.b0 = (const char*)(ws + WS_LRUBT) + (size_t)pn * 256 * 128 * 2; u.b1 = u.b0 + (size_t)128 * 128 * 2;
            u.out = (char*)(ws + WS_G) + ((size_t)pm * 256 * 4096 + (size_t)pn * 256) * 2; u.ldc = 4096; return true;
        } else if constexpr (KIND == K_R3) {
            if (Ll >= 512) return false; const int L = (int)Ll; const int bh = L >> 3, cc = L & 7, b = bh >> 2, h = bh & 3;
            u.a = (const char*)dout + ((size_t)bh * 2048 + (size_t)cc * 256) * 768 * 2;
            u.b0 = (const char*)(ws + WS_BCAT) + (size_t)(bh * 8 + cc) * 256 * 768 * 2; u.b1 = u.b0 + (size_t)128 * 768 * 2;
            u.out = (char*)(ws + WS_O) + ((size_t)(b * 2048 + cc * 256) * 1024 + (size_t)h * 256) * 2; u.ldc = 1024; return true;
        } else if constexpr (KIND == K_OUT) {
            if (Ll >= 1024) return false; int pm, pn; pg8::static_map((int)Ll, 128, 8, pm, pn);
            u.a = (const char*)(ws + WS_MRG) + (size_t)pm * 256 * DM * 2; u.b0 = (const char*)(ws + WS_WOT) + (size_t)pn * 256 * DM * 2; u.b1 = u.b0 + (size_t)128 * DM * 2;
            u.out = nullptr; u.ldc = DM; u.r0 = pm * 256; u.c0 = pn * 256; return true;
        } else if constexpr (KIND == K_MOE1) {
            const int* tile_e = (const int*)(ws + WS_TILEE); const int ntl = tile_e[1024];
            if (Ll >= (long)ntl * 16) return false; int mt, pn; pg8::static_map((int)Ll, ntl, 16, mt, pn);
            const int e = tile_e[mt];
            u.a = (const char*)(ws + WS_H2); u.gidx = (const int*)(ws + WS_TOKSLOT) + mt * 256;
            u.b0 = (const char*)(ws + WS_WG) + ((size_t)e * 2048 + (size_t)pn * 128) * DM; u.b1 = (const char*)(ws + WS_WU) + ((size_t)e * 2048 + (size_t)pn * 128) * DM;
            u.out = (char*)(ws + WS_ACT) + ((size_t)mt * 256 * DM + (size_t)pn * 128); u.ldc = DM; u.r0 = mt * 256; u.c0 = pn * 128; u.e = e; return true;
        } else {
            const int* tile_e = (const int*)(ws + WS_TILEE); const int ntl = tile_e[1024];
            if (Ll >= (long)ntl * 8) return false; int mt, pn; pg8::static_map((int)Ll, ntl, 8, mt, pn);
            const int e = tile_e[mt];
            u.a = (const char*)(ws + WS_ACT) + (size_t)mt * 256 * DM;
            u.b0 = (const char*)(ws + WS_WD) + ((size_t)e * 2048 + (size_t)pn * 256) * DM; u.b1 = u.b0 + (size_t)128 * DM;
            u.out = (char*)(ws + WS_Y) + ((size_t)mt * 256 * DM + (size_t)pn * 256) * 2; u.ldc = DM; u.r0 = mt * 256; u.c0 = pn * 256; u.e = e; return true;
        }
    }
};

struct EpiPlain {
    static constexpr bool PERM = true;
    __device__ __forceinline__ void operator()(const f32x4 (&acc)[2][2][4][2], const pg8::Unit& u, int wr, int wc, int fr, int fq) const {
        int rz = wr * 64 + fr, cz = wc * 32 + 8 * fq; asm volatile("" : "+v"(rz), "+v"(cz));
        bf16_t* base = (bf16_t*)u.out + (size_t)rz * u.ldc + cz;
#pragma unroll
        for (int ai = 0; ai < 2; ++ai)
#pragma unroll
            for (int m = 0; m < 4; ++m) { bf16_t* rowp = base + (size_t)(ai * 128 + m * 16) * u.ldc;
#pragma unroll
                for (int bj = 0; bj < 2; ++bj) { const f32x4 v0 = acc[ai][bj][m][0], v1 = acc[ai][bj][m][1];
                    u32x4 w; w.x = cvt_pk_bf16(v0[0], v0[1]); w.y = cvt_pk_bf16(v0[2], v0[3]); w.z = cvt_pk_bf16(v1[0], v1[1]); w.w = cvt_pk_bf16(v1[2], v1[3]);
                    *(u32x4*)(rowp + bj * 128) = w; } }
    }
};
struct EpiScores {
    static constexpr bool PERM = true;
    __device__ __forceinline__ void operator()(const f32x4 (&acc)[2][2][4][2], const pg8::Unit& u, int wr, int wc, int fr, int fq) const {
        const float lg = l2gamma(u.e);
        int iz = wr * 64 + fr, cz = wc * 32 + 8 * fq; asm volatile("" : "+v"(iz), "+v"(cz));
        bf16_t* base = (bf16_t*)u.out + (size_t)iz * u.ldc + cz;
#pragma unroll
        for (int ai = 0; ai < 2; ++ai)
#pragma unroll
            for (int m = 0; m < 4; ++m) { const int i = ai * 128 + m * 16 + iz; bf16_t* rowp = base + (size_t)(ai * 128 + m * 16) * u.ldc;
#pragma unroll
                for (int bj = 0; bj < 2; ++bj) { float o[8];
#pragma unroll
                    for (int n = 0; n < 2; ++n)
#pragma unroll
                        for (int q = 0; q < 4; ++q) { const int j = bj * 128 + cz + 4 * n + q; const int d = i - j; const int ad = d < 0 ? -d : d;
                            o[n * 4 + q] = acc[ai][bj][m][n][q] * fexp2((float)(ad - i - 1) * lg); }
                    *(u32x4*)(rowp + bj * 128) = pack8(o); }
                __builtin_amdgcn_sched_barrier(0); }
    }
};
struct EpiOut {
    static constexpr bool PERM = false;
    const float* x; const float* mod; float* X1;
    __device__ __forceinline__ void operator()(const f32x4 (&acc)[2][2][4][2], const pg8::Unit& u, int wr, int wc, int fr, int fq) const {
        int rz = wr * 64 + fr, cz = wc * 32 + 4 * fq; asm volatile("" : "+v"(rz), "+v"(cz));
        const int row0 = u.r0 + rz, col0 = u.c0 + cz; const int b = u.r0 >> 11;
        f32x4 gv[2][2];
#pragma unroll
        for (int bj = 0; bj < 2; ++bj)
#pragma unroll
            for (int n = 0; n < 2; ++n) gv[bj][n] = *(const f32x4*)(mod + (size_t)b * MODW + 2 * DM + col0 + bj * 128 + n * 16);
#pragma unroll
        for (int ai = 0; ai < 2; ++ai)
#pragma unroll
            for (int m = 0; m < 4; ++m) { const size_t off = (size_t)(row0 + ai * 128 + m * 16) * DM + col0;
#pragma unroll
                for (int bj = 0; bj < 2; ++bj)
#pragma unroll
                    for (int n = 0; n < 2; ++n) { const f32x4 xv = *(const f32x4*)(x + off + bj * 128 + n * 16);
                        *(f32x4*)(X1 + off + bj * 128 + n * 16) = xv + gv[bj][n] * acc[ai][bj][m][n]; }
                asm volatile("" ::: "memory"); }
    }
};
struct EpiSwiGLU {
    static constexpr bool PERM = true;
    const float* bg; const float* bu;
    __device__ __forceinline__ void operator()(const f32x4 (&acc)[2][2][4][2], const pg8::Unit& u, int wr, int wc, int fr, int fq) const {
        int rz = wr * 64 + fr, cl = wc * 32 + 8 * fq; asm volatile("" : "+v"(rz), "+v"(cl));
        const float* pg_ = bg + (size_t)u.e * DM + u.c0 + cl; const float* pu_ = bu + (size_t)u.e * DM + u.c0 + cl;
        const f32x4 g0 = *(const f32x4*)pg_, g1 = *(const f32x4*)(pg_ + 4), u0 = *(const f32x4*)pu_, u1 = *(const f32x4*)(pu_ + 4);
        unsigned char* base = (unsigned char*)u.out + (size_t)rz * DM + cl;
#pragma unroll
        for (int ai = 0; ai < 2; ++ai)
#pragma unroll
            for (int m = 0; m < 4; ++m) { float o[8];
#pragma unroll
                for (int n = 0; n < 2; ++n)
#pragma unroll
                    for (int q = 0; q < 4; ++q) { float gl = acc[ai][0][m][n][q] * (1.0f / (H2_SCALE * W_SCALE)) + (n ? g1[q] : g0[q]); float up = acc[ai][1][m][n][q] * (1.0f / (H2_SCALE * W_SCALE)) + (n ? u1[q] : u0[q]);
                        gl = fminf(gl, 7.0f); up = fminf(fmaxf(up, -7.0f), 7.0f);
                        o[n * 4 + q] = ACT_SCALE * (up + 1.0f) * gl * frcp(1.0f + fexp2(gl * (-1.702f * 1.44269504089f))); }
                *(u32x2*)(base + (size_t)(ai * 128 + m * 16) * DM) = pack8_fp8(o); }
    }
};
struct EpiDown {
    static constexpr bool PERM = true;
    const float* bd; const float* gate;
    __device__ __forceinline__ void operator()(const f32x4 (&acc)[2][2][4][2], const pg8::Unit& u, int wr, int wc, int fr, int fq) const {
        int rz = wr * 64 + fr, cl = wc * 32 + 8 * fq; asm volatile("" : "+v"(rz), "+v"(cl));
        const float* pb = bd + (size_t)u.e * DM + u.c0 + cl; const float* gp = gate + u.r0 + rz;
        bf16_t* base = (bf16_t*)u.out + (size_t)rz * DM + cl;
#pragma unroll
        for (int bj = 0; bj < 2; ++bj) { const f32x4 b0 = *(const f32x4*)(pb + bj * 128), b1 = *(const f32x4*)(pb + bj * 128 + 4);
#pragma unroll
            for (int ai = 0; ai < 2; ++ai)
#pragma unroll
                for (int m = 0; m < 4; ++m) { const float gt = gp[ai * 128 + m * 16];
                    const f32x4 v0 = (acc[ai][bj][m][0] * (1.0f / (ACT_SCALE * W_SCALE)) + b0) * gt, v1 = (acc[ai][bj][m][1] * (1.0f / (ACT_SCALE * W_SCALE)) + b1) * gt;
                    u32x4 w; w.x = cvt_pk_bf16(v0[0], v0[1]); w.y = cvt_pk_bf16(v0[2], v0[3]); w.z = cvt_pk_bf16(v1[0], v1[1]); w.w = cvt_pk_bf16(v1[2], v1[3]);
                    *(u32x4*)(base + (size_t)(ai * 128 + m * 16) * DM + bj * 128) = w; }
            __builtin_amdgcn_sched_barrier(0); }
    }
};

struct Frame {
    LAS unsigned char* lds; unsigned char* ws; float* out; const float* const* in;
    int tid, lane, wave, G, bid;
};
#define INP(k) (F.in[k])

__device__ __forceinline__ void p0_transpose_item(const float* W, int K, int N, bf16_t* WT, int row_off, LAS float* scr, int item, int lane) {
    const int nblk = N / 32, kb = item / nblk, nb = item % nblk, k0 = 64 * kb, n0 = 32 * nb;
#pragma unroll 8
    for (int i = 0; i < 32; ++i) { const int kk = 2 * i + (lane >> 5); scr[kk * 33 + (lane & 31)] = W[(size_t)(k0 + kk) * N + n0 + (lane & 31)]; }
    LDS_WAIT(); asm volatile("" ::: "memory");
    const int c = lane & 7;
#pragma unroll
    for (int j = 0; j < 4; ++j) { const int n = (lane >> 3) + 8 * j; const LAS float* s = scr + (8 * c) * 33 + n;
        u32x4 o; o.x = cvt_pk_bf16(s[0 * 33], s[1 * 33]); o.y = cvt_pk_bf16(s[2 * 33], s[3 * 33]); o.z = cvt_pk_bf16(s[4 * 33], s[5 * 33]); o.w = cvt_pk_bf16(s[6 * 33], s[7 * 33]);
        *(u32x4*)(WT + (size_t)(row_off + n0 + n) * K + k0 + 8 * c) = o; }
    LDS_WAIT(); asm volatile("" ::: "memory");
}
__device__ __forceinline__ void p0_tr8_item(const float* W, int K, int N, unsigned char* WT, LAS unsigned* T, int item, int lane) {
    const int nblk = N / 32, kb = item / nblk, nb = item % nblk, k0 = 128 * kb, n0 = 32 * nb;
    const int c = lane & 7, r = lane >> 3;
    f32x4 v[4][4];
    const float* src = W + (size_t)(k0 + 4 * r) * N + n0 + 4 * c;
#pragma unroll
    for (int p = 0; p < 4; ++p)
#pragma unroll
        for (int i = 0; i < 4; ++i) v[p][i] = __builtin_nontemporal_load((const f32x4*)(src + (size_t)(32 * p + i) * N));
#pragma unroll
    for (int p = 0; p < 4; ++p)
#pragma unroll
        for (int j = 0; j < 4; ++j) T[(4 * c + j) * 33 + r + 8 * p] = pk4_fp8(v[p][0][j] * W_SCALE, v[p][1][j] * W_SCALE, v[p][2][j] * W_SCALE, v[p][3][j] * W_SCALE);
    LDS_WAIT(); asm volatile("" ::: "memory");
#pragma unroll
    for (int p = 0; p < 4; ++p) { const int n = r + 8 * p; const LAS unsigned* t = T + n * 33 + 4 * c;
        u32x4 o; o.x = t[0]; o.y = t[1]; o.z = t[2]; o.w = t[3];
        *(u32x4*)(WT + (size_t)(n0 + n) * K + k0 + 16 * c) = o; }
    LDS_WAIT(); asm volatile("" ::: "memory");
}
__device__ __forceinline__ void p0_ada_item(Frame& F, int item, LAS float* scr) {
    const int ks = item & 7, cg = item >> 3, n = cg * 64 + F.lane;
    const float* c = INP(IN_C); const float* cc = INP(IN_CCTX); const float* W = INP(IN_ADAW);
    float acc[17];
#pragma unroll
    for (int b = 0; b < 17; ++b) acc[b] = 0.f;
    for (int sub = 0; sub < 4; ++sub) {
        const int k0 = ks * 256 + sub * 64;
#pragma unroll
        for (int b = 0; b < 17; ++b) { const float v = b < 16 ? c[b * DM + k0 + F.lane] : cc[k0 + F.lane]; scr[F.lane * 20 + b] = v * fsigmoid(v); }
        LDS_WAIT(); asm volatile("" ::: "memory");
#pragma unroll 8
        for (int kk = 0; kk < 64; ++kk) { const float w = W[(size_t)(k0 + kk) * MODW + n];
            const LAS f32x4* sp = (const LAS f32x4*)(scr + kk * 20); const f32x4 s0 = sp[0], s1 = sp[1], s2 = sp[2], s3 = sp[3]; const float s16 = scr[kk * 20 + 16];
#pragma unroll
            for (int q = 0; q < 4; ++q) { acc[q] += s0[q] * w; acc[4 + q] += s1[q] * w; acc[8 + q] += s2[q] * w; acc[12 + q] += s3[q] * w; }
            acc[16] += s16 * w; }
        LDS_WAIT(); asm volatile("" ::: "memory");
    }
    float* mp = (float*)(F.ws + WS_MODP) + (size_t)ks * 17 * MODW + n;
#pragma unroll
    for (int b = 0; b < 17; ++b) mp[(size_t)b * MODW] = acc[b];
}
__device__ __forceinline__ void p0_prologue(Frame& F) {
    LAS float* scr = (LAS float*)(F.lds + F.wave * 16384);
    const int gw = F.bid * 8 + F.wave, NGW = F.G * 8;
    constexpr int I_ADA = 1536, I_IN = 32 * 192, I_OUT = 32 * 64, I_EXP = 96 * 1024, I_LRU = 32 * 8;
    constexpr int NITEMS = I_ADA + I_IN + I_OUT + I_EXP + I_LRU;
    for (int it = gw; it < NITEMS; it += NGW) {
        int r = it;
        if (r < I_ADA) { p0_ada_item(F, r, scr); continue; } r -= I_ADA;
        if (r < I_IN) { p0_transpose_item(INP(IN_WIN), DM, DIN, (bf16_t*)(F.ws + WS_WINT), 0, scr, r, F.lane); continue; } r -= I_IN;
        if (r < I_OUT) { p0_transpose_item(INP(IN_WOUT), DM, DM, (bf16_t*)(F.ws + WS_WOT), 0, scr, r, F.lane); continue; } r -= I_OUT;
        if (r < I_EXP) { const int m = r >> 10, item = r & 1023, which = m >> 5, e = m & 31;
            const float* W = (which == 0 ? INP(IN_WG) : (which == 1 ? INP(IN_WU) : INP(IN_WD))) + (size_t)e * DM * DM;
            unsigned char* WT = (unsigned char*)(F.ws + (which == 0 ? WS_WG : (which == 1 ? WS_WU : WS_WD))) + (size_t)e * DM * DM;
            p0_tr8_item(W, DM, DM, WT, (LAS unsigned*)scr, item, F.lane); continue; } r -= I_EXP;
        { const int mat = r >> 3, item = r & 7, which = mat >> 4, d = (mat >> 3) & 1, h = mat & 7;
          const float* W = (which == 0 ? INP(IN_LWA) : INP(IN_LWX)) + (size_t)(d * 8 + h) * 128 * 128;
          p0_transpose_item(W, 128, 128, (bf16_t*)(F.ws + WS_LRUBT), h * 512 + d * 256 + which * 128, scr, item, F.lane); }
    }
    const int gt = F.bid * 512 + F.tid, NGT = F.G * 512;
    for (int i = gt; i < 64 * 64; i += NGT) { const int pos = i >> 6, fi = i & 63;
        const float inv = fexp2(-(float)fi * (13.2877123795f / 64.0f)); const float rev = (float)pos * inv * 0.15915494309f; const float fr_ = rev - floorf(rev);
        ((f32x2*)(F.ws + WS_CS))[i] = (f32x2){__builtin_amdgcn_cosf(fr_), __builtin_amdgcn_sinf(fr_)}; }
    for (int i = gt; i < NE * DM; i += NGT) { const int e = i >> 11, k = i & 2047; ((float*)(F.ws + WS_RWT))[i] = INP(IN_RW)[(size_t)k * NE + e]; }
    for (int i = gt; i < 2 * DL; i += NGT) { const float lam = INP(IN_LAM)[i]; const float z = fexp(-lam);
        const float sp = z < 0.03f ? z * (1.0f - z * (0.5f - z * (0.33333333f - 0.25f * z))) : __builtin_amdgcn_logf(1.0f + z) * 0.69314718056f;
        ((float*)(F.ws + WS_C8SP))[i] = -8.0f * sp; }
}
__device__ __forceinline__ void p0b_mod(Frame& F) {
    const float* mp = (const float*)(F.ws + WS_MODP); float* mod = (float*)(F.ws + WS_MOD);
    for (int i = F.bid * 512 + F.tid; i < 17 * MODW; i += F.G * 512) { float s = INP(IN_ADAB)[i % MODW];
#pragma unroll
        for (int ks = 0; ks < 8; ++ks) s += mp[(size_t)ks * 17 * MODW + i];
        mod[i] = s; }
}
__device__ __forceinline__ void p1_norm1(Frame& F) {
    const float* mod = (const float*)(F.ws + WS_MOD); const float* n1g = INP(IN_N1G);
    bf16_t* HX = (bf16_t*)(F.ws + WS_HX);
    for (int row = F.bid * 8 + F.wave; row < NT; row += F.G * 8) {
        const int b = row < NL ? (row >> 11) : 16;
        const float* xr = row < NL ? INP(IN_X) + (size_t)row * DM : INP(IN_CTX) + (size_t)(row - NL) * DM;
        const f32x4* xp = (const f32x4*)xr + F.lane; f32x4 v[8]; float s = 0.f;
#pragma unroll
        for (int j = 0; j < 8; ++j) { v[j] = xp[64 * j]; s += (v[j].x * v[j].x + v[j].y * v[j].y) + (v[j].z * v[j].z + v[j].w * v[j].w); }
        const float rstd = 1.0f / sqrtf(wave_sum(s) * (1.0f / DM) + EPS);
        const f32x4* gp = (const f32x4*)n1g + F.lane; const f32x4* shp = (const f32x4*)(mod + (size_t)b * MODW) + F.lane; const f32x4* scp = (const f32x4*)(mod + (size_t)b * MODW + DM) + F.lane;
        u32x2* op = (u32x2*)(HX + (size_t)row * DM) + F.lane;
#pragma unroll
        for (int j = 0; j < 8; ++j) { const f32x4 g = gp[64 * j], sh = shp[64 * j], sc = scp[64 * j];
            const f32x4 y = v[j] * rstd * g * (1.0f + sc) + sh; u32x2 w; w.x = cvt_pk_bf16(y.x, y.y); w.y = cvt_pk_bf16(y.z, y.w); op[64 * j] = w; }
    }
}

__device__ __forceinline__ void p3_prep(Frame& F) {
    const int gt = F.bid * 512 + F.tid, NGT = F.G * 512;
    const f32x2* cs = (const f32x2*)(F.ws + WS_CS);
    {
        const bf16_t* Q = (const bf16_t*)(F.ws + WS_Q); const bf16_t* KT = (const bf16_t*)(F.ws + WS_KT);
        bf16_t* KR = (bf16_t*)(F.ws + WS_KR); bf16_t* AC = (bf16_t*)F.out;
        for (int it = gt; it < NL * 128; it += NGT) {
            const int row = it >> 7, sub = it & 127, which = sub >> 6, h = (sub >> 4) & 3, half = (sub >> 3) & 1, c8 = sub & 7;
            const int p = row & 2047, comp = half == 0 ? (p >> 6) : (p & 63);
            const int d1 = half * 128 + c8 * 8;
            const bf16_t* src = (which == 0 ? Q : KT) + (size_t)row * 1024 + h * 256 + d1;
            float x1[8], x2[8], o1[8], o2[8]; unpack8(*(const u32x4*)src, x1); unpack8(*(const u32x4*)(src + 64), x2);
            const f32x4* cp = (const f32x4*)(cs + comp * 64 + c8 * 8);
#pragma unroll
            for (int q = 0; q < 4; ++q) { const f32x4 t = cp[q];
                o1[2 * q] = x1[2 * q] * t.x - x2[2 * q] * t.y; o2[2 * q] = x1[2 * q] * t.y + x2[2 * q] * t.x;
                o1[2 * q + 1] = x1[2 * q + 1] * t.z - x2[2 * q + 1] * t.w; o2[2 * q + 1] = x1[2 * q + 1] * t.w + x2[2 * q + 1] * t.z; }
            if (which == 0) {
                const int i = row & 255, b = row >> 11, t_ = row & 2047; const float lg = l2gamma(h);
                const float ff = fexp2((float)(i + 1) * lg), fb = fexp2((float)(256 - i) * lg);
                bf16_t* dst = AC + ((size_t)(b * 4 + h) * 2048 + t_) * 768 + 256 + d1;
                float a[8], c[8];
#pragma unroll
                for (int q = 0; q < 8; ++q) { a[q] = o1[q] * ff; c[q] = o1[q] * fb; }
                *(u32x4*)dst = pack8(a); *(u32x4*)(dst + 256) = pack8(c);
#pragma unroll
                for (int q = 0; q < 8; ++q) { a[q] = o2[q] * ff; c[q] = o2[q] * fb; }
                *(u32x4*)(dst + 64) = pack8(a); *(u32x4*)(dst + 256 + 64) = pack8(c);
            } else {
                bf16_t* dst = KR + (size_t)row * 1024 + h * 256 + d1;
#pragma unroll
                for (int q = 0; q < 8; ++q) { o1[q] *= 0.0625f; o2[q] *= 0.0625f; }
                *(u32x4*)dst = pack8(o1); *(u32x4*)(dst + 64) = pack8(o2);
            }
        }
    }
    {
        const bf16_t* KTR = (const bf16_t*)(F.ws + WS_KTR); bf16_t* KDF = (bf16_t*)(F.ws + WS_KDF); bf16_t* KDB = (bf16_t*)(F.ws + WS_KDB);
        constexpr int NTG = NT / 8;
        for (int it = gt; it < 512 * NTG; it += NGT) {
            const int fp = it / NTG, tg = it - fp * NTG, h = fp >> 7, half = (fp >> 6) & 1, cc = fp & 63;
            const int f1 = h * 256 + half * 128 + cc, tok0 = tg * 8;
            float x1[8], x2[8], o1[8], o2[8];
            unpack8(*(const u32x4*)(KTR + (size_t)f1 * NT + tok0), x1); unpack8(*(const u32x4*)(KTR + (size_t)(f1 + 64) * NT + tok0), x2);
            if (tok0 < NL) {
                const int p0 = tok0 & 2047;
#pragma unroll
                for (int q = 0; q < 8; ++q) { const int comp = half == 0 ? (p0 >> 6) : ((p0 & 63) + q); const f32x2 t = cs[comp * 64 + cc];
                    o1[q] = x1[q] * t.x - x2[q] * t.y; o2[q] = x1[q] * t.y + x2[q] * t.x; }
            } else {
#pragma unroll
                for (int q = 0; q < 8; ++q) { o1[q] = x1[q]; o2[q] = x2[q]; }
            }
            const float lg = l2gamma(h); const int j0 = tok0 & 255;
            float a1[8], a2[8], c1[8], c2[8];
#pragma unroll
            for (int q = 0; q < 8; ++q) { const float df = 0.0625f * fexp2((float)(255 - j0 - q) * lg), db = 0.0625f * fexp2((float)(j0 + q) * lg);
                a1[q] = o1[q] * df; a2[q] = o2[q] * df; c1[q] = o1[q] * db; c2[q] = o2[q] * db; }
            *(u32x4*)(KDF + (size_t)f1 * NT + tok0) = pack8(a1); *(u32x4*)(KDF + (size_t)(f1 + 64) * NT + tok0) = pack8(a2);
            *(u32x4*)(KDB + (size_t)f1 * NT + tok0) = pack8(c1); *(u32x4*)(KDB + (size_t)(f1 + 64) * NT + tok0) = pack8(c2);
        }
    }
    {
        const bf16_t* UR = (const bf16_t*)(F.ws + WS_URAW); bf16_t* U = (bf16_t*)(F.ws + WS_U);
        const float* cw = INP(IN_CONVW); const float* cb = INP(IN_CONVB);
        for (int it = gt; it < NT * 128; it += NGT) {
            const int row = it >> 7, ch = (it & 127) * 8;
            const int t = row < NL ? (row & 2047) : ((row - NL) & 255), Ls = row < NL ? SEQ : NCTX;
            float o[8]; { const f32x4 b0 = *(const f32x4*)(cb + ch), b1 = *(const f32x4*)(cb + ch + 4);
#pragma unroll
                for (int q = 0; q < 4; ++q) { o[q] = b0[q]; o[4 + q] = b1[q]; } }
#pragma unroll
            for (int tap = 0; tap < 4; ++tap) { const int tt = t + tap - 1;
                if (tt >= 0 && tt < Ls) { float x[8]; unpack8(*(const u32x4*)(UR + (size_t)(row + tap - 1) * 1024 + ch), x);
                    const f32x4 w0 = *(const f32x4*)(cw + tap * DL + ch), w1 = *(const f32x4*)(cw + tap * DL + ch + 4);
#pragma unroll
                    for (int q = 0; q < 4; ++q) { o[q] += x[q] * w0[q]; o[4 + q] += x[4 + q] * w1[q]; } } }
            *(u32x4*)(U + (size_t)row * 1024 + ch) = pack8(o);
        }
    }
}

struct LruCh { float ba0, ba1, bx0, bx1, k0, k1; };
__device__ __forceinline__ void lru_ab(const LruCh& P, unsigned rw, unsigned iw, unsigned uw, float& a0, float& b0, float& a1, float& b1) {
    const float r0 = fsigmoid(bf_lo(rw) + P.ba0), r1 = fsigmoid(bf_hi(rw) + P.ba1), i0 = fsigmoid(bf_lo(iw) + P.bx0), i1 = fsigmoid(bf_hi(iw) + P.bx1);
    a0 = fexp(P.k0 * r0); a1 = fexp(P.k1 * r1);
    b0 = sqrtf(fmaxf((1.0f - a0) * (1.0f + a0), 0.f)) * (i0 * bf_lo(uw)); b1 = sqrtf(fmaxf((1.0f - a1) * (1.0f + a1), 0.f)) * (i1 * bf_hi(uw));
}
__device__ __forceinline__ int lru_row(int b, int d, int s) {
    if (s < NCTX) return NL + b * NCTX + (d ? (NCTX - 1 - s) : s);
    const int pl = s - NCTX; return b * SEQ + (d ? (SEQ - 1 - pl) : pl);
}
__device__ __forceinline__ void p5_prefix_and_summaries(Frame& F) {
    {
        const bf16_t* SL = (const bf16_t*)(F.ws + WS_SLOC); bf16_t* BC = (bf16_t*)(F.ws + WS_BCAT);
        for (int it = F.bid * 512 + F.tid; it < 128 * 8192; it += F.G * 512) {
            const int bhd = it >> 13, el = (it & 8191) * 8, bh = bhd >> 1, dir = bhd & 1, h = bh & 3, e = el >> 8, d = el & 255;
            const float cd = fexp2(256.0f * l2gamma(h));
            const bf16_t* sl = SL + (size_t)bhd * 9 * 65536 + el;
            float s[8]; unpack8(*(const u32x4*)sl, s);
#pragma unroll
            for (int st = 0; st < 8; ++st) { const int c = dir ? 7 - st : st;
                *(u32x4*)(BC + ((size_t)(bh * 8 + c) * 256 + e) * 768 + 256 + dir * 256 + d) = pack8(s);
                if (st < 7) { float x[8]; unpack8(*(const u32x4*)(sl + (size_t)(c + 1) * 65536), x);
#pragma unroll
                    for (int q = 0; q < 8; ++q) s[q] = s[q] * cd + x[q]; } }
        }
    }
    {
        const bf16_t* G = (const bf16_t*)(F.ws + WS_G); const bf16_t* U = (const bf16_t*)(F.ws + WS_U); const float* k8 = (const float*)(F.ws + WS_C8SP);
        float* SA = (float*)(F.ws + WS_SUMA); float* SB = (float*)(F.ws + WS_SUMB);
        const int ch = 2 * F.tid, blk = ch >> 7, cj = ch & 127;
        for (int it = F.bid; it < NB * 2 * NLCH; it += F.G) {
            const int ck = it % NLCH, bd = it / NLCH, d = bd & 1, b = bd >> 1;
            LruCh P; P.ba0 = INP(IN_LBA)[d * DL + ch]; P.ba1 = INP(IN_LBA)[d * DL + ch + 1]; P.bx0 = INP(IN_LBX)[d * DL + ch]; P.bx1 = INP(IN_LBX)[d * DL + ch + 1];
            P.k0 = k8[d * DL + ch]; P.k1 = k8[d * DL + ch + 1];
            const int gcol = blk * 512 + d * 256 + cj;
            float A0 = 1.f, A1 = 1.f, B0 = 0.f, B1 = 0.f;
#pragma unroll 8
            for (int t = 0; t < LCH; ++t) { const int row = lru_row(b, d, ck * LCH + t);
                const unsigned rw = *(const unsigned*)(G + (size_t)row * 4096 + gcol), iw = *(const unsigned*)(G + (size_t)row * 4096 + gcol + 128), uw = *(const unsigned*)(U + (size_t)row * 1024 + ch);
                float a0, b0, a1, b1; lru_ab(P, rw, iw, uw, a0, b0, a1, b1);
                A0 *= a0; A1 *= a1; B0 = a0 * B0 + b0; B1 = a1 * B1 + b1; }
            const size_t o = ((size_t)bd * NLCH + ck) * DL + ch;
            *(f32x2*)(SA + o) = (f32x2){A0, A1}; *(f32x2*)(SB + o) = (f32x2){B0, B1};
        }
    }
}
__device__ __forceinline__ void p6_carries(Frame& F) {
    const float* SA = (const float*)(F.ws + WS_SUMA); const float* SB = (const float*)(F.ws + WS_SUMB); float* CI = (float*)(F.ws + WS_CIN);
    for (int it = F.bid * 512 + F.tid; it < NB * 2 * DL; it += F.G * 512) {
        const int bd = it >> 10, ch = it & 1023; float h = 0.f;
#pragma unroll 8
        for (int ck = 0; ck < NLCH; ++ck) { const size_t o = ((size_t)bd * NLCH + ck) * DL + ch; CI[o] = h; h = SA[o] * h + SB[o]; }
    }
}
__device__ __forceinline__ float gelu_tanh(float y) { const float t = 0.7978845608f * (y + 0.044715f * y * y * y); const float e = fexp(2.0f * t); return 0.5f * y * (2.0f - 2.0f * frcp(e + 1.0f)); }
__device__ __forceinline__ void p7_merge(Frame& F) {
    bf16_t* MRG = (bf16_t*)(F.ws + WS_MRG);
    {
        const bf16_t* O = (const bf16_t*)(F.ws + WS_O); const bf16_t* GT = (const bf16_t*)(F.ws + WS_GT); const float* rng = INP(IN_RNG);
        for (int it = F.bid * 8 + F.wave; it < NL * 4; it += F.G * 8) {
            const int row = it >> 2, h = it & 3; const size_t off = (size_t)row * 1024 + h * 256 + 4 * F.lane;
            const u32x2 ow = *(const u32x2*)(O + off), gw = *(const u32x2*)(GT + off);
            const float o0 = bf_lo(ow.x), o1 = bf_hi(ow.x), o2 = bf_lo(ow.y), o3 = bf_hi(ow.y);
            const float mu = wave_sum((o0 + o1) + (o2 + o3)) * (1.0f / 256.0f);
            const float d0 = o0 - mu, d1 = o1 - mu, d2 = o2 - mu, d3 = o3 - mu;
            const float rstd = 1.0f / sqrtf(wave_sum((d0 * d0 + d1 * d1) + (d2 * d2 + d3 * d3)) * (1.0f / 256.0f) + EPS);
            const f32x4 gn = *(const f32x4*)(rng + h * 256 + 4 * F.lane);
            const float g0 = bf_lo(gw.x), g1 = bf_hi(gw.x), g2 = bf_lo(gw.y), g3 = bf_hi(gw.y);
            u32x2 w; w.x = cvt_pk_bf16(d0 * rstd * gn.x * g0 * fsigmoid(g0), d1 * rstd * gn.y * g1 * fsigmoid(g1)); w.y = cvt_pk_bf16(d2 * rstd * gn.z * g2 * fsigmoid(g2), d3 * rstd * gn.w * g3 * fsigmoid(g3));
            *(u32x2*)(MRG + (size_t)row * DM + h * 256 + 4 * F.lane) = w;
        }
    }
    {
        const bf16_t* G = (const bf16_t*)(F.ws + WS_G); const bf16_t* U = (const bf16_t*)(F.ws + WS_U); const bf16_t* YB = (const bf16_t*)(F.ws + WS_YB);
        const float* k8 = (const float*)(F.ws + WS_C8SP); const float* CI = (const float*)(F.ws + WS_CIN); const float* lng = INP(IN_LNG);
        LAS float* red = (LAS float*)(F.lds + LDS_MISC);
        LAS f32x2* hfl = (LAS f32x2*)F.lds + F.tid;
        const int ch = 2 * F.tid, blk = ch >> 7, cj = ch & 127;
        for (int it = F.bid; it < NB * (SEQ / LCH); it += F.G) {
            const int b = it >> 6, lc = it & 63; const int row0 = b * SEQ + lc * LCH;
            {
                LruCh P; P.ba0 = INP(IN_LBA)[ch]; P.ba1 = INP(IN_LBA)[ch + 1]; P.bx0 = INP(IN_LBX)[ch]; P.bx1 = INP(IN_LBX)[ch + 1]; P.k0 = k8[ch]; P.k1 = k8[ch + 1];
                const f32x2 ci = *(const f32x2*)(CI + ((size_t)(b * 2 + 0) * NLCH + 8 + lc) * DL + ch); float h0 = ci.x, h1 = ci.y;
                const bf16_t* gp = G + (size_t)row0 * 4096 + blk * 512 + cj; const bf16_t* up = U + (size_t)row0 * 1024 + ch;
#pragma unroll 4
                for (int t = 0; t < LCH; ++t) {
                    const unsigned rw = *(const unsigned*)(gp + (size_t)t * 4096), iw = *(const unsigned*)(gp + (size_t)t * 4096 + 128), uw = *(const unsigned*)(up + (size_t)t * 1024);
                    float a0, b0, a1, b1; lru_ab(P, rw, iw, uw, a0, b0, a1, b1);
                    h0 = a0 * h0 + b0; h1 = a1 * h1 + b1; hfl[t * 512] = (f32x2){h0, h1}; }
            }
            {
                LruCh P; P.ba0 = INP(IN_LBA)[DL + ch]; P.ba1 = INP(IN_LBA)[DL + ch + 1]; P.bx0 = INP(IN_LBX)[DL + ch]; P.bx1 = INP(IN_LBX)[DL + ch + 1]; P.k0 = k8[DL + ch]; P.k1 = k8[DL + ch + 1];
                const f32x2 ci = *(const f32x2*)(CI + ((size_t)(b * 2 + 1) * NLCH + 8 + (63 - lc)) * DL + ch); float h0 = ci.x, h1 = ci.y;
                const bf16_t* gp = G + (size_t)row0 * 4096 + blk * 512 + 256 + cj; const bf16_t* up = U + (size_t)row0 * 1024 + ch; const bf16_t* yp = YB + (size_t)row0 * 1024 + ch;
#pragma unroll 4
                for (int t = LCH - 1; t >= 0; --t) {
                    const unsigned rw = *(const unsigned*)(gp + (size_t)t * 4096), iw = *(const unsigned*)(gp + (size_t)t * 4096 + 128), uw = *(const unsigned*)(up + (size_t)t * 1024);
                    float a0, b0, a1, b1; lru_ab(P, rw, iw, uw, a0, b0, a1, b1);
                    h0 = a0 * h0 + b0; h1 = a1 * h1 + b1;
                    const unsigned yw = *(const unsigned*)(yp + (size_t)t * 1024); const f32x2 hf = hfl[t * 512];
                    const float w0 = (hf.x + h0) * gelu_tanh(bf_lo(yw)), w1 = (hf.y + h1) * gelu_tanh(bf_hi(yw));
                    hfl[t * 512] = (f32x2){w0, w1};
                    const float sq = wave_sum(w0 * w0 + w1 * w1); if (F.lane == 0) red[F.wave * LCH + t] = sq; }
            }
            __syncthreads();
            const f32x2 gn = *(const f32x2*)(lng + ch);
#pragma unroll 4
            for (int t = 0; t < LCH; ++t) { float sq = 0.f;
#pragma unroll
                for (int w = 0; w < 8; ++w) sq += red[w * LCH + t];
                const float rstd = 1.0f / sqrtf(sq * (1.0f / DL) + EPS); const f32x2 v = hfl[t * 512];
                *(unsigned*)(MRG + (size_t)(row0 + t) * DM + DR + ch) = cvt_pk_bf16(v.x * rstd * gn.x, v.y * rstd * gn.y); }
            __syncthreads();
        }
    }
}
__device__ __forceinline__ void p9_router(Frame& F) {
    const float* X1 = F.out; const float* mod = (const float*)(F.ws + WS_MOD); const float* n2g = INP(IN_N2G); const float* rwT = (const float*)(F.ws + WS_RWT); const float* rb = INP(IN_RB);
    unsigned char* H2 = (unsigned char*)(F.ws + WS_H2); int* topi = (int*)(F.ws + WS_TOPI); float* topg = (float*)(F.ws + WS_TOPG); int* cnt16 = (int*)(F.ws + WS_CNT16);
    LAS float* lgs = (LAS float*)(F.lds + F.wave * 16384); LAS int* ids = (LAS int*)(F.lds + F.wave * 16384 + 4096);
    const int rl = F.lane & 15, kq = F.lane >> 4;
    for (int g = F.bid * 8 + F.wave; g < NL / 16; g += F.G * 8) {
        const int tok = g * 16 + rl, b = tok >> 11;
        const f32x4* xp = (const f32x4*)(X1 + (size_t)tok * DM) + 4 * kq;
        float s = 0.f;
#pragma unroll 4
        for (int Q = 0; Q < 32; ++Q) {
#pragma unroll
            for (int j = 0; j < 4; ++j) { const f32x4 x = xp[16 * Q + j]; s += (x.x * x.x + x.y * x.y) + (x.z * x.z + x.w * x.w); } }
        s += __shfl_xor(s, 16); s += __shfl_xor(s, 32);
        const float rstd = 1.0f / sqrtf(s * (1.0f / DM) + EPS);
        const f32x4* gp = (const f32x4*)n2g + 4 * kq; const f32x4* shp = (const f32x4*)(mod + (size_t)b * MODW + 3 * DM) + 4 * kq; const f32x4* scp = (const f32x4*)(mod + (size_t)b * MODW + 4 * DM) + 4 * kq;
        const f32x4* w0p = (const f32x4*)(rwT + (size_t)rl * DM) + 4 * kq; const f32x4* w1p = (const f32x4*)(rwT + (size_t)(16 + rl) * DM) + 4 * kq;
        u32x4* hp = (u32x4*)(H2 + (size_t)tok * DM) + kq;
        f32x4 acc0 = (f32x4){0.f, 0.f, 0.f, 0.f}, acc1 = (f32x4){0.f, 0.f, 0.f, 0.f};
#pragma unroll 2
        for (int Q = 0; Q < 32; ++Q) {
            u32x4 hw;
#pragma unroll
            for (int j = 0; j < 4; ++j) {
                const f32x4 x = xp[16 * Q + j], gg = gp[16 * Q + j], sh = shp[16 * Q + j], sc = scp[16 * Q + j], w0 = w0p[16 * Q + j], w1 = w1p[16 * Q + j];
                const f32x4 h = x * rstd * gg * (1.0f + sc) + sh;
                hw[j] = pk4_fp8(h.x * H2_SCALE, h.y * H2_SCALE, h.z * H2_SCALE, h.w * H2_SCALE);
                acc0 = __builtin_amdgcn_mfma_f32_16x16x4f32(h.x, w0.x, acc0, 0, 0, 0); acc1 = __builtin_amdgcn_mfma_f32_16x16x4f32(h.x, w1.x, acc1, 0, 0, 0);
                acc0 = __builtin_amdgcn_mfma_f32_16x16x4f32(h.y, w0.y, acc0, 0, 0, 0); acc1 = __builtin_amdgcn_mfma_f32_16x16x4f32(h.y, w1.y, acc1, 0, 0, 0);
                acc0 = __builtin_amdgcn_mfma_f32_16x16x4f32(h.z, w0.z, acc0, 0, 0, 0); acc1 = __builtin_amdgcn_mfma_f32_16x16x4f32(h.z, w1.z, acc1, 0, 0, 0);
                acc0 = __builtin_amdgcn_mfma_f32_16x16x4f32(h.w, w0.w, acc0, 0, 0, 0); acc1 = __builtin_amdgcn_mfma_f32_16x16x4f32(h.w, w1.w, acc1, 0, 0, 0);
            }
            hp[4 * Q] = hw;
        }
        const float rb0 = rb[rl], rb1 = rb[16 + rl];
#pragma unroll
        for (int j = 0; j < 4; ++j) { lgs[(4 * kq + j) * 33 + rl] = acc0[j] + rb0; lgs[(4 * kq + j) * 33 + 16 + rl] = acc1[j] + rb1; }
        LDS_WAIT(); asm volatile("" ::: "memory");
        if (F.lane < 16) {
            float v0 = -3.0e38f, v1 = -3.0e38f, v2 = -3.0e38f, v3 = -3.0e38f; int i0 = 0, i1 = 0, i2 = 0, i3 = 0;
#pragma unroll
            for (int e = 0; e < NE; ++e) { float x = lgs[F.lane * 33 + e]; int xi = e;
                if (x > v0) { const float tv = v0; const int ti = i0; v0 = x; i0 = xi; x = tv; xi = ti; }
                if (x > v1) { const float tv = v1; const int ti = i1; v1 = x; i1 = xi; x = tv; xi = ti; }
                if (x > v2) { const float tv = v2; const int ti = i2; v2 = x; i2 = xi; x = tv; xi = ti; }
                if (x > v3) { v3 = x; i3 = xi; } }
            const float e1 = fexp(v1 - v0), e2 = fexp(v2 - v0), e3 = fexp(v3 - v0); const float inv = 1.0f / (1.0f + e1 + e2 + e3);
            const int t2 = g * 16 + F.lane;
            *(int4*)(topi + (size_t)t2 * 4) = make_int4(i0, i1, i2, i3); *(f32x4*)(topg + (size_t)t2 * 4) = (f32x4){inv, e1 * inv, e2 * inv, e3 * inv};
            ids[F.lane * 4 + 0] = i0; ids[F.lane * 4 + 1] = i1; ids[F.lane * 4 + 2] = i2; ids[F.lane * 4 + 3] = i3;
        }
        LDS_WAIT(); asm volatile("" ::: "memory");
        if (F.lane < NE) { int c = 0;
#pragma unroll 16
            for (int q = 0; q < 64; ++q) c += (ids[q] == F.lane) ? 1 : 0;
            cnt16[(size_t)g * NE + F.lane] = c; }
        LDS_WAIT(); asm volatile("" ::: "memory");
    }
}
__device__ __forceinline__ void p10_routing(Frame& F) {
    const int* cnt16 = (const int*)(F.ws + WS_CNT16); const int* topi = (const int*)(F.ws + WS_TOPI); const float* topg = (const float*)(F.ws + WS_TOPG);
    int* tokslot = (int*)(F.ws + WS_TOKSLOT); float* gateslot = (float*)(F.ws + WS_GATESLOT); int* slotof = (int*)(F.ws + WS_SLOTOF); int* tile_e = (int*)(F.ws + WS_TILEE);
    LAS int* L = (LAS int*)(F.lds);
    for (int seg = F.bid; seg < 256; seg += F.G) {
        { const int e = F.tid & 31, part = F.tid >> 5; int tot = 0, pre = 0;
#pragma unroll 1
          for (int s = part * 16; s < part * 16 + 16; ++s) { int ss = 0;
#pragma unroll 2
              for (int gi = 0; gi < 8; ++gi) ss += cnt16[(size_t)(8 * s + gi) * NE + e];
              tot += ss; if (s < seg) pre += ss; }
          L[part * 32 + e] = tot; L[512 + part * 32 + e] = pre; }
        __syncthreads();
        if (F.tid < 32) { int tot = 0, pre = 0;
#pragma unroll
            for (int p = 0; p < 16; ++p) { tot += L[p * 32 + F.tid]; pre += L[512 + p * 32 + F.tid]; }
            L[1024 + F.tid] = tot; L[1056 + F.tid] = (tot + 255) & ~255; L[1088 + F.tid] = pre; }
        __syncthreads();
        if (F.tid < 32) { int base = 0; for (int e = 0; e < 32; ++e) base += (e < F.tid) ? L[1056 + e] : 0; L[1120 + F.tid] = base; }
        __syncthreads();
        {
            const int g = 8 * seg + F.wave; LAS int* offs = L + 2048 + F.wave * 128; LAS int* ids = offs + 32;
            if (F.lane < 32) { int o = L[1120 + F.lane] + L[1088 + F.lane]; for (int gj = 0; gj < F.wave; ++gj) o += cnt16[(size_t)(8 * seg + gj) * NE + F.lane]; offs[F.lane] = o; }
            int4 my = make_int4(0, 0, 0, 0); f32x4 mg = (f32x4){0.f, 0.f, 0.f, 0.f}; const int tok = g * 16 + (F.lane & 15);
            if (F.lane < 16) { my = *(const int4*)(topi + (size_t)tok * 4); mg = *(const f32x4*)(topg + (size_t)tok * 4);
                ids[F.lane * 4 + 0] = my.x; ids[F.lane * 4 + 1] = my.y; ids[F.lane * 4 + 2] = my.z; ids[F.lane * 4 + 3] = my.w; }
            LDS_WAIT(); asm volatile("" ::: "memory");
            if (F.lane < 16) { int r0 = 0, r1 = 0, r2 = 0, r3 = 0;
                for (int t2 = 0; t2 < 16; ++t2) { if (t2 < F.lane) {
#pragma unroll
                        for (int k = 0; k < 4; ++k) { const int x = ids[t2 * 4 + k]; r0 += (x == my.x); r1 += (x == my.y); r2 += (x == my.z); r3 += (x == my.w); } } }
                const int s0 = offs[my.x] + r0, s1 = offs[my.y] + r1, s2 = offs[my.z] + r2, s3 = offs[my.w] + r3;
                tokslot[s0] = tok; tokslot[s1] = tok; tokslot[s2] = tok; tokslot[s3] = tok;
                gateslot[s0] = mg.x; gateslot[s1] = mg.y; gateslot[s2] = mg.z; gateslot[s3] = mg.w;
                *(int4*)(slotof + (size_t)tok * 4) = make_int4(s0, s1, s2, s3); }
        }
        if (seg < 32) { const int beg = L[1120 + seg] + L[1024 + seg], end = L[1120 + seg] + L[1056 + seg];
            for (int s = beg + F.tid; s < end; s += 512) { tokslot[s] = 0; gateslot[s] = 0.f; } }
        if (seg == 0) { const int ntl = (L[1120 + 31] + L[1056 + 31]) >> 8;
            for (int mt = F.tid; mt < ntl; mt += 512) { int e = 0;
                for (int q = 0; q < 32; ++q) { const int lo = L[1120 + q] >> 8, hi = (L[1120 + q] + L[1056 + q]) >> 8; if (mt >= lo && mt < hi) e = q; }
                tile_e[mt] = e; }
            if (F.tid == 0) tile_e[1024] = ntl; }
        __syncthreads();
    }
}
__device__ __forceinline__ void p13_final(Frame& F) {
    const float* mod = (const float*)(F.ws + WS_MOD); const bf16_t* Y = (const bf16_t*)(F.ws + WS_Y); const int* slotof = (const int*)(F.ws + WS_SLOTOF); const float* fng = INP(IN_FNG);
    for (int row = F.bid * 8 + F.wave; row < NL; row += F.G * 8) {
        const int b = row >> 11; const int4 sl = *(const int4*)(slotof + (size_t)row * 4);
        f32x4* xp = (f32x4*)(F.out + (size_t)row * DM) + F.lane; const f32x4* g2p = (const f32x4*)(mod + (size_t)b * MODW + 5 * DM) + F.lane;
        const u32x2* y0 = (const u32x2*)(Y + (size_t)sl.x * DM) + F.lane; const u32x2* y1 = (const u32x2*)(Y + (size_t)sl.y * DM) + F.lane;
        const u32x2* y2 = (const u32x2*)(Y + (size_t)sl.z * DM) + F.lane; const u32x2* y3 = (const u32x2*)(Y + (size_t)sl.w * DM) + F.lane;
        f32x4 v[8]; float s = 0.f;
#pragma unroll
        for (int j = 0; j < 8; ++j) { const u32x2 a = y0[64 * j], bq = y1[64 * j], c = y2[64 * j], d = y3[64 * j]; const f32x4 g2 = g2p[64 * j];
            f32x4 m; m.x = (bf_lo(a.x) + bf_lo(bq.x)) + (bf_lo(c.x) + bf_lo(d.x)); m.y = (bf_hi(a.x) + bf_hi(bq.x)) + (bf_hi(c.x) + bf_hi(d.x));
            m.z = (bf_lo(a.y) + bf_lo(bq.y)) + (bf_lo(c.y) + bf_lo(d.y)); m.w = (bf_hi(a.y) + bf_hi(bq.y)) + (bf_hi(c.y) + bf_hi(d.y));
            v[j] = xp[64 * j] + g2 * m; s += (v[j].x * v[j].x + v[j].y * v[j].y) + (v[j].z * v[j].z + v[j].w * v[j].w); }
        const float rstd = 1.0f / sqrtf(wave_sum(s) * (1.0f / DM) + EPS);
        const f32x4* fp = (const f32x4*)fng + F.lane;
#pragma unroll
        for (int j = 0; j < 8; ++j) xp[64 * j] = v[j] * rstd * fp[64 * j];
    }
}

constexpr int N_PHASES = 15;
__global__ void __launch_bounds__(512, 2) mk_fwd(Args args) {
    extern __shared__ __attribute__((aligned(16))) unsigned char lds_raw[];
    Frame F;
    F.lds = (LAS unsigned char*)lds_raw; F.ws = args.ws; F.out = args.out; F.in = args.in;
    F.tid = threadIdx.x; F.lane = F.tid & 63; F.wave = __builtin_amdgcn_readfirstlane(F.tid >> 6); F.G = gridDim.x; F.bid = blockIdx.x;
    volatile LAS unsigned* MISC = (volatile LAS unsigned*)(F.lds + LDS_MISC + 4096);
    if (F.tid < 64) MISC[F.tid] = 0u;
    __syncthreads();
    const int lo = args.ph_lo, hi = args.ph_hi;
    XcdBarrier bar; bar.bar = (unsigned*)(args.ws + WS_CTL) + CW_BAR; bar.x = 0; bar.st = nullptr;
    if (hi - lo > 1) bar = xcd_barrier_post((unsigned*)(args.ws + WS_CTL) + CW_BAR, MISC);
#ifndef ONLY_PH
#define ONLY_PH -1
#endif
#define IN(k) (lo <= (k) && (k) < hi && (ONLY_PH < 0 || ONLY_PH == (k)))
#define SEAM(k) do { if (IN(k) && IN((k) + 1)) xcd_barrier(bar); } while (0)
    LAS unsigned char* ring = F.lds;
#ifndef DUP_MASK
#define DUP_MASK 0
#endif
#define REP(k) for (int _r = 0; _r < ((DUP_MASK >> (k)) & 1) + 1; ++_r, (void)((_r < ((DUP_MASK >> (k)) & 1) + 1) ? (xcd_barrier(bar), 0) : 0))

    if (IN(0)) REP(0) { p0_prologue(F); } SEAM(0);
    if (IN(1)) REP(1) { p0b_mod(F); } SEAM(1);
    if (IN(2)) REP(2) { p1_norm1(F); } SEAM(2);
    if (IN(3)) REP(3) { Sched<K_INPROJ> S{F.G, F.bid, F.ws, (unsigned char*)F.out}; EpiPlain E; pg8::gemm_phase<EpiPlain, Sched<K_INPROJ>, false>(ring, pg8::Cfg{DM * 2, DM * 2, 32}, S, E); } SEAM(3);
    if (IN(4)) REP(4) { p3_prep(F); } SEAM(4);
    if (IN(5)) REP(5) {
        { Sched<K_SCORES> S{F.G, F.bid, F.ws, (unsigned char*)F.out}; EpiScores E; pg8::gemm_phase<EpiScores, Sched<K_SCORES>, false>(ring, pg8::Cfg{768 * 2, 1024 * 2, 4}, S, E); }
        { Sched<K_STATE> S{F.G, F.bid, F.ws, (unsigned char*)F.out}; EpiPlain E; pg8::gemm_phase<EpiPlain, Sched<K_STATE>, false>(ring, pg8::Cfg{768 * 2, NT * 2, 4}, S, E); }
        { Sched<K_GATES> S{F.G, F.bid, F.ws, (unsigned char*)F.out}; EpiPlain E; pg8::gemm_phase<EpiPlain, Sched<K_GATES>, false>(ring, pg8::Cfg{1024 * 2, 128 * 2, 2}, S, E); }
    } SEAM(5);
    if (IN(6)) REP(6) { p5_prefix_and_summaries(F); } SEAM(6);
    if (IN(7)) REP(7) { p6_carries(F);
        { Sched<K_R3> S{F.G, F.bid, F.ws, (unsigned char*)F.out}; EpiPlain E; pg8::gemm_phase<EpiPlain, Sched<K_R3>, false>(ring, pg8::Cfg{768 * 2, 768 * 2, 12}, S, E); } } SEAM(7);
    if (IN(8)) REP(8) { p7_merge(F); } SEAM(8);
    if (IN(9)) REP(9) { Sched<K_OUT> S{F.G, F.bid, F.ws, (unsigned char*)F.out}; EpiOut E{INP(IN_X), (const float*)(F.ws + WS_MOD), F.out}; pg8::gemm_phase<EpiOut, Sched<K_OUT>, false>(ring, pg8::Cfg{DM * 2, DM * 2, 32}, S, E); } SEAM(9);
    if (IN(10)) REP(10) { p9_router(F); } SEAM(10);
    if (IN(11)) REP(11) { p10_routing(F); } SEAM(11);
    if (IN(12)) REP(12) { Sched<K_MOE1> S{F.G, F.bid, F.ws, (unsigned char*)F.out}; EpiSwiGLU E{INP(IN_BG), INP(IN_BU)}; pg8::gemm_phase<EpiSwiGLU, Sched<K_MOE1>, true, true>(ring, pg8::Cfg{DM, DM, 16}, S, E); } SEAM(12);
    if (IN(13)) REP(13) { Sched<K_MOE2> S{F.G, F.bid, F.ws, (unsigned char*)F.out}; EpiDown E{INP(IN_BD), (const float*)(F.ws + WS_GATESLOT)}; pg8::gemm_phase<EpiDown, Sched<K_MOE2>, false, true>(ring, pg8::Cfg{DM, DM, 16}, S, E); } SEAM(13);
    if (IN(14)) { p13_final(F); }
#undef IN
#undef SEAM
}

extern "C" void kernel_launch(void* const* d_in, const int* in_sizes, int n_in, void* d_out, int out_size, void* d_ws, size_t ws_size, hipStream_t stream) {
    static int grid = 0;
    if (grid == 0) {
        if (n_in != 28 || out_size != NL * DM || ws_size < WS_END) { fprintf(stderr, "kernel_launch: unexpected shapes (n_in %d, out %d, ws %zu); nothing launched\n", n_in, out_size, ws_size); grid = -1; return; }
        int dev = 0, cus = 0, per_cu = 0;
        if (hipGetDevice(&dev) != hipSuccess || hipDeviceGetAttribute(&cus, hipDeviceAttributeMultiprocessorCount, dev) != hipSuccess) { grid = -1; return; }
        if (hipFuncSetAttribute((const void*)mk_fwd, hipFuncAttributeMaxDynamicSharedMemorySize, LDS_BYTES) != hipSuccess) { fprintf(stderr, "kernel_launch: hipFuncSetAttribute failed\n"); grid = -1; return; }
        if (hipOccupancyMaxActiveBlocksPerMultiprocessor(&per_cu, (const void*)mk_fwd, 512, LDS_BYTES) != hipSuccess || per_cu < 1) fprintf(stderr, "kernel_launch: occupancy query reports %d blocks per CU\n", per_cu);
        (void)hipGetLastError();
        grid = cus;
    }
    if (grid < 0) return;
    if (hipMemsetAsync((char*)d_ws + WS_CTL, 0, 131072, stream) != hipSuccess) return;
    Args a{};
    for (int i = 0; i < 28; ++i) a.in[i] = (const float*)d_in[i];
    a.out = (float*)d_out; a.ws = (unsigned char*)d_ws; a.pad = 0;
#if MK_MULTI
    for (int p = 0; p < N_PHASES; ++p) { a.ph_lo = p; a.ph_hi = p + 1; a.li = p; hipLaunchKernelGGL(mk_fwd, dim3(grid), dim3(512), LDS_BYTES, stream, a); }
#else
    a.ph_lo = 0; a.ph_hi = N_PHASES; a.li = 0;
    hipLaunchKernelGGL(mk_fwd, dim3(grid), dim3(512), LDS_BYTES, stream, a);
#endif
}
```
